# Optimizing an MI355X kernel written in HIP

```python
import jax, jax.numpy as jnp
from jax import lax
import numpy as np

D_MODEL = 1024
BATCH = 8
SEQ = 2048
DEPTH = 2

GRID_W = 64
CTX_LEN = 256
HEAD_DIM = 64
N_Q_HEADS = 16
N_KV_HEADS = 4
Q_PER_KV = N_Q_HEADS // N_KV_HEADS
ATTN_WIDTH = N_Q_HEADS * HEAD_DIM
KV_WIDTH = N_KV_HEADS * HEAD_DIM
CONV_WIDTH = D_MODEL
CONV_K = 3
N_BRANCH = 2
Q_BLOCK = 128
ROPE_THETA = 10000.0
EPS = 1e-6
ATTN_SCALE = HEAD_DIM ** -0.5
PROJ_SIZES = (ATTN_WIDTH, KV_WIDTH, KV_WIDTH, ATTN_WIDTH, CONV_WIDTH, CONV_WIDTH, CONV_WIDTH, CONV_WIDTH, N_BRANCH * D_MODEL)
PROJ_WIDTH = 2 * ATTN_WIDTH + 2 * KV_WIDTH + 4 * CONV_WIDTH + N_BRANCH * D_MODEL

kernel_name = "hybrid_gqa_shortconv_dit_prefix"


def rms_norm(x, g):
    x32 = x.astype(jnp.float32)
    y = x32 * lax.rsqrt(jnp.mean(x32 * x32, axis=-1, keepdims=True) + EPS)
    return y.astype(x.dtype) * g


def modulation(cond, w_ada, b_ada):
    m = jax.nn.silu(cond) @ w_ada + b_ada
    return jnp.split(m, 3, axis=-1)


def modulate(x, g, shift, scale):
    return rms_norm(x, g) * (1.0 + scale) + shift


def split_proj(p):
    points = []
    acc = 0
    for s in PROJ_SIZES[:-1]:
        acc += s
        points.append(acc)
    return jnp.split(p, points, axis=-1)


def axial_rope(n_tokens, dtype):
    rows = n_tokens // GRID_W
    row = jnp.repeat(jnp.arange(rows), GRID_W).astype(jnp.float32)
    col = jnp.tile(jnp.arange(GRID_W), rows).astype(jnp.float32)
    half = HEAD_DIM // 2
    inv = ROPE_THETA ** (-jnp.arange(0, half, 2, dtype=jnp.float32) / half)
    ang_r = row[:, None] * inv[None, :]
    ang_c = col[:, None] * inv[None, :]
    ang = jnp.concatenate([ang_r, ang_r, ang_c, ang_c], axis=-1)
    return jnp.cos(ang)[:, None, :].astype(dtype), jnp.sin(ang)[:, None, :].astype(dtype)


def rotate_axial(x):
    x1, x2, x3, x4 = jnp.split(x, 4, axis=-1)
    return jnp.concatenate([-x2, x1, -x4, x3], axis=-1)


def apply_rope(x, cos, sin):
    return x * cos + rotate_axial(x) * sin


def gqa(q, k, v):
    b, lq = q.shape[:2]
    qg = q.reshape(b, lq, N_KV_HEADS, Q_PER_KV, HEAD_DIM)
    s = jnp.einsum('bqkgd,btkd->bkgqt', qg, k) * ATTN_SCALE
    p = jax.nn.softmax(s.astype(jnp.float32), axis=-1).astype(v.dtype)
    o = jnp.einsum('bkgqt,btkd->bqkgd', p, v)
    return o.reshape(b, lq, ATTN_WIDTH)


def latent_attention(q, k_all, v_all):
    b, s = q.shape[:2]
    nb = s // Q_BLOCK
    qb = q.reshape(b, nb, Q_BLOCK, N_Q_HEADS, HEAD_DIM).transpose(1, 0, 2, 3, 4)
    o = lax.map(lambda blk: gqa(blk, k_all, v_all), qb)
    return o.transpose(1, 0, 2, 3).reshape(b, s, ATTN_WIDTH)


def project(h, w_in, qn_g, kn_g):
    b, l = h.shape[:2]
    q, k, v, za, xc, bc, cc, zc, gl = split_proj(h @ w_in)
    q = rms_norm(q.reshape(b, l, N_Q_HEADS, HEAD_DIM), qn_g)
    k = rms_norm(k.reshape(b, l, N_KV_HEADS, HEAD_DIM), kn_g)
    v = v.reshape(b, l, N_KV_HEADS, HEAD_DIM)
    return q, k, v, za, xc, bc, cc, zc, gl


def context_kv(h, w_in, kn_g):
    b, l = h.shape[:2]
    kv = h @ w_in[:, ATTN_WIDTH:ATTN_WIDTH + 2 * KV_WIDTH]
    k, v = jnp.split(kv, 2, axis=-1)
    k = rms_norm(k.reshape(b, l, N_KV_HEADS, HEAD_DIM), kn_g)
    return k, v.reshape(b, l, N_KV_HEADS, HEAD_DIM)


def short_conv(u, w, bias):
    y = lax.conv_general_dilated(u, w[:, None, :].astype(u.dtype), window_strides=(1,), padding=((1, 1),),
                                 dimension_numbers=('NWC', 'WIO', 'NWC'), feature_group_count=CONV_WIDTH)
    return y + bias


def merge_output(attn_o, za, xc, bc, cc, zc, gl, conv_w, conv_b, w_attn_br, w_conv_br, b_gate, w_out):
    attn_br = (attn_o * jax.nn.silu(za)) @ w_attn_br
    y = bc * short_conv(cc * xc, conv_w, conv_b)
    conv_br = (y * jax.nn.silu(zc)) @ w_conv_br
    gates = jax.nn.sigmoid(gl.reshape(*gl.shape[:-1], N_BRANCH, D_MODEL) + b_gate)
    merged = gates[..., 0, :] * attn_br + gates[..., 1, :] * conv_br
    return merged @ w_out


def setup_inputs(seed: int = 0) -> dict:
    key = jax.random.key(seed)
    ks = jax.random.split(key, 16)
    f = jnp.float32
    n = lambda k, shape: jax.random.normal(k, shape, dtype=f)
    return {
        "x": n(ks[0], (BATCH, SEQ, D_MODEL)),
        "c": n(ks[1], (BATCH, D_MODEL)),
        "ctx": n(ks[2], (BATCH, CTX_LEN, D_MODEL)),
        "c_ctx": n(ks[3], (D_MODEL,)),
        "norm_g": 1.0 + 0.02 * n(ks[4], (DEPTH, D_MODEL)),
        "w_ada": n(ks[5], (DEPTH, D_MODEL, 3 * D_MODEL)) * (0.5 * D_MODEL ** -0.5),
        "b_ada": 0.02 * n(ks[6], (DEPTH, 3 * D_MODEL)),
        "w_in": n(ks[7], (DEPTH, D_MODEL, PROJ_WIDTH)) * D_MODEL ** -0.5,
        "q_norm_g": 1.0 + 0.02 * n(ks[8], (DEPTH, HEAD_DIM)),
        "k_norm_g": 1.0 + 0.02 * n(ks[9], (DEPTH, HEAD_DIM)),
        "conv_w": n(ks[10], (DEPTH, CONV_K, CONV_WIDTH)) * CONV_K ** -0.5,
        "conv_b": 0.02 * n(ks[11], (DEPTH, CONV_WIDTH)),
        "w_attn_br": n(ks[12], (DEPTH, ATTN_WIDTH, D_MODEL)) * ATTN_WIDTH ** -0.5,
        "w_conv_br": n(ks[13], (DEPTH, CONV_WIDTH, D_MODEL)) * CONV_WIDTH ** -0.5,
        "b_gate": 0.02 * n(ks[14], (DEPTH, N_BRANCH, D_MODEL)),
        "w_out": n(ks[15], (DEPTH, D_MODEL, D_MODEL)) * D_MODEL ** -0.5,
    }


def reference(x, c, ctx, c_ctx, norm_g, w_ada, b_ada, w_in, q_norm_g, k_norm_g, conv_w, conv_b,
              w_attn_br, w_conv_br, b_gate, w_out):
    s = x.shape[1]
    cos, sin = axial_rope(s, x.dtype)
    for l in range(DEPTH):
        last = l == DEPTH - 1
        sh_x, sc_x, g_x = [m[:, None, :] for m in modulation(c, w_ada[l], b_ada[l])]
        sh_c, sc_c, g_c = modulation(c_ctx, w_ada[l], b_ada[l])
        hx = modulate(x, norm_g[l], sh_x, sc_x)
        hc = modulate(ctx, norm_g[l], sh_c, sc_c)

        qx, kx, vx, za, xc, bc, cc, zc, gl = project(hx, w_in[l], q_norm_g[l], k_norm_g[l])
        qx = apply_rope(qx, cos, sin)
        kx = apply_rope(kx, cos, sin)
        if last:
            kc, vc = context_kv(hc, w_in[l], k_norm_g[l])
        else:
            qc, kc, vc, za_c, xc_c, bc_c, cc_c, zc_c, gl_c = project(hc, w_in[l], q_norm_g[l], k_norm_g[l])

        k_all = jnp.concatenate([kc, kx], axis=1)
        v_all = jnp.concatenate([vc, vx], axis=1)
        attn_x = latent_attention(qx, k_all, v_all)
        out_x = merge_output(attn_x, za, xc, bc, cc, zc, gl, conv_w[l], conv_b[l],
                             w_attn_br[l], w_conv_br[l], b_gate[l], w_out[l])
        if not last:
            attn_c = gqa(qc, kc, vc)
            out_c = merge_output(attn_c, za_c, xc_c, bc_c, cc_c, zc_c, gl_c, conv_w[l], conv_b[l],
                                 w_attn_br[l], w_conv_br[l], b_gate[l], w_out[l])
            ctx = ctx + g_c * out_c
        x = x + g_x * out_x
    return x
```

```cpp
#include <hip/hip_runtime.h>
#include <hip/hip_bf16.h>
#include <cstdio>
#include <cstdint>

#define MK_N_LAUNCHES 1
#ifndef MK_N_LAUNCHES
#define MK_N_LAUNCHES 1
#endif

constexpr int DM = 1024, NBATCH = 8, SEQ = 2048, CTXL = 256, NLAT = NBATCH * SEQ, NCTX = NBATCH * CTXL, NROW = NLAT + NCTX;
constexpr int PROJ = 8704, KVLEN = CTXL + SEQ, KVP = 256;
constexpr float EPS = 1e-6f;
constexpr float C2 = 0.125f * 1.4426950408889634f;

struct Args { const float* in[16]; float* out; unsigned char* ws; int ph_lo, ph_hi; };
enum In { I_X = 0, I_C, I_CTX, I_CCTX, I_NORMG, I_WADA, I_BADA, I_WIN, I_QNG, I_KNG, I_CONVW, I_CONVB, I_WABR, I_WCBR, I_BGATE, I_WOUT };
#define ARGP(A, i, z) (((const __attribute__((address_space(4))) Args*)__builtin_amdgcn_kernarg_segment_ptr())->in[(i) + (z)])

#define LAS __attribute__((address_space(3)))
#define GAS __attribute__((address_space(1)))
typedef unsigned short bf16_t;
typedef short bf16x8 __attribute__((ext_vector_type(8)));
typedef float f32x4 __attribute__((ext_vector_type(4)));
typedef unsigned u32x4 __attribute__((ext_vector_type(4)));
typedef unsigned u32x2 __attribute__((ext_vector_type(2)));

typedef float f32x2_c __attribute__((ext_vector_type(2))); typedef __bf16 bf16x2_c __attribute__((ext_vector_type(2)));
__device__ __forceinline__ unsigned cvt_pk_bf16(float lo, float hi) { f32x2_c v = {lo, hi}; bf16x2_c b = __builtin_convertvector(v, bf16x2_c); return __builtin_bit_cast(unsigned, b); }
__device__ __forceinline__ float bf_lo(unsigned w) { return __uint_as_float(w << 16); }
__device__ __forceinline__ float bf_hi(unsigned w) { return __uint_as_float(w & 0xffff0000u); }
__device__ __forceinline__ float sigmoid_f(float x) { return __builtin_amdgcn_rcpf(1.0f + __expf(-x)); }
__device__ __forceinline__ float silu_f(float x) { return x * sigmoid_f(x); }
__device__ __forceinline__ float silu_ps(float a) { const float e = __builtin_amdgcn_exp2f(a); return a * __builtin_amdgcn_rcpf(__builtin_fmaf(e, -1.4426950408889634f, -1.4426950408889634f)); }
__device__ __forceinline__ u32x4 pack8(const f32x4& a, const f32x4& b) { u32x4 w; w.x = cvt_pk_bf16(a[0], a[1]); w.y = cvt_pk_bf16(a[2], a[3]); w.z = cvt_pk_bf16(b[0], b[1]); w.w = cvt_pk_bf16(b[2], b[3]); return w; }

namespace pg8 {
constexpr int BM = 256, BK = 64, HALF = 128, HTB = HALF * BK * 2, STAGE_BYTES = 8 * HTB, NXCD = 8, WGM = 3, KD = 1024;
constexpr size_t TSTEP = (size_t)BM * KD * 2;
__host__ __device__ __forceinline__ int lds_byte(int r, int c) { const int st = (r >> 4) * 2 + (c >> 5), rr = r & 15, cc = c & 31, ob = rr * 64 + cc * 2; return st * 1024 + (ob ^ (((ob >> 9) & 1) << 5)); }
__host__ __device__ __forceinline__ void stage_rc(int b, int& R, int& C) { const int st = b / 1024, sb = b % 1024, swz = sb ^ (((sb >> 9) & 1) << 5); R = (st >> 1) * 16 + swz / 64; C = (st & 1) * 32 + (swz % 64) / 2; }

struct Unit { const char* A; const char* B; int pm, pn, kind, chain; };

enum Kind { EK_Q = 0, EK_K = 1, EK_V = 2, EK_ZA = 3, EK_XC = 4, EK_BZ = 5, EK_GL = 6, EK_BR1 = 7, EK_BR2 = 8, EK_OUT = 9 };

struct GSched {
    int base, stride, cnt, xlast, npre;
    int mode  , nM, nN, pn0, nwg, nx, xpm, xpn, xk0, xk1;
    const char *A0, *A1, *B0, *B1;
    __device__ __forceinline__ bool next(int i, Unit& u) const {
        if (mode == 3) { if (i >= nx) return false; u.A = i ? A1 : A0; u.B = i ? B1 : B0; u.pm = xpm; u.pn = xpn; u.kind = i ? xk1 : xk0; u.chain = (nx == 2 && i == 0) ? 1 : 0; return true; }
        if (i < npre) { u.A = A0 + (size_t)xpm * TSTEP; u.B = B0 + (size_t)xpn * TSTEP; u.pm = xpm; u.pn = xpn; u.kind = xk0; u.chain = 0; return true; }
        i -= npre;
        const int ti = (mode == 1) ? (i >> 1) : i, seg = (mode == 1) ? (i & 1) : 0;
        if (ti > cnt || (ti == cnt && xlast < 0)) return false;
        const long L = ti == cnt ? (long)xlast : (long)base + (long)ti * stride; int pm, pn;
        if (L >= nwg) return false;
        {
            int wgid = (int)L; { const int q = nwg / NXCD, r = nwg % NXCD, xcd = wgid % NXCD, off = wgid / NXCD; wgid = (xcd < r ? xcd * (q + 1) : r * (q + 1) + (xcd - r) * q) + off; }
            const int nig = WGM * nN, gid = wgid / nig, fm = gid * WGM, gsz = (nM - fm) < WGM ? (nM - fm) : WGM;
            pm = fm + ((wgid % nig) % gsz); pn = pn0 + (wgid % nig) / gsz;
        }
        u.pm = pm; u.pn = pn;
        if (mode == 0) { u.A = A0 + (size_t)pm * TSTEP; u.B = B0 + (size_t)pn * TSTEP; u.chain = 0;
            u.kind = pn < 4 ? EK_Q : pn == 4 ? EK_K : pn == 5 ? EK_V : pn < 10 ? EK_ZA : pn < 18 ? EK_XC : pn < 26 ? EK_BZ : EK_GL; }
        else if (mode == 1) { u.A = (seg ? A1 : A0) + (size_t)pm * TSTEP; u.B = (seg ? B1 : B0) + (size_t)pn * TSTEP; u.kind = seg ? EK_BR2 : EK_BR1; u.chain = seg ? 0 : 1; }
        else { u.A = A0 + (size_t)pm * TSTEP; u.B = B0 + (size_t)pn * TSTEP; u.kind = EK_OUT; u.chain = 0; }
        return true;
    }
};

struct EpiP { unsigned char* ws; float* out; int l; const LAS float* tab; };
constexpr size_t EMiB = 1u << 20;
constexpr size_t E_MOD = 1 * EMiB, E_ROPEC = E_MOD + 256 * 1024, E_ROPES = E_ROPEC + 4096, E_HX = 48 * EMiB, E_Q = 84 * EMiB;
__device__ __forceinline__ size_t e_k(int l) { return l ? 2 * EMiB : 120 * EMiB; }
__device__ __forceinline__ size_t e_v(int l) { return l ? 11 * EMiB : 129 * EMiB; }
__device__ __forceinline__ size_t e_sza(int l) { return l ? 120 * EMiB : 138 * EMiB; }
__device__ __forceinline__ size_t e_u(int l) { return l ? 152 * EMiB : 174 * EMiB; }
__device__ __forceinline__ size_t e_yz(int l) { return l ? 184 * EMiB : 210 * EMiB; }
constexpr size_t E_GCTX = 254 * EMiB, E_X1B = 216 * EMiB, E_YZC = 250 * EMiB;
__device__ __forceinline__ float* ctx1_half(unsigned char* ws, int r, int h) { return (float*)(ws + (h ? E_GCTX : E_YZC) + (size_t)r * 2048); }
__device__ __forceinline__ unsigned char* g_rows(unsigned char* ws, float* out, int l, bool isctx, int row0) {
    return isctx ? ws + E_GCTX + (size_t)(row0 - NLAT) * 2048 : (unsigned char*)out + (size_t)row0 * 2048; }
__device__ __forceinline__ unsigned q8(float g, unsigned qmin) { unsigned q = (unsigned)(g * 255.0f + 0.5f); return q < qmin ? qmin : q; }
__device__ __forceinline__ void epilogue(const f32x4 (&acc)[2][2][4][2], const Unit& u, int wr, int wc, int fr, int fq, const EpiP& EP, const Args& AR) {
    int z = 0; asm volatile("" : "+v"(fr), "+v"(fq), "+s"(z));
    unsigned char* const ws = EP.ws; const int l = EP.l;
    struct { bf16_t *Q, *Kb, *Vb, *SZA, *U, *Wb; const float *ropec, *ropes, *mod; } P;
    P.Q = (bf16_t*)(ws + E_Q); P.Kb = (bf16_t*)(ws + e_k(l)); P.Vb = (bf16_t*)(ws + e_v(l)); P.SZA = (bf16_t*)(ws + e_sza(l)); P.U = (bf16_t*)(ws + e_u(l)); P.Wb = (bf16_t*)(ws + e_yz(l));
    P.ropec = (const float*)(ws + E_ROPEC); P.ropes = (const float*)(ws + E_ROPES); P.mod = (const float*)(ws + E_MOD) + (size_t)l * 9 * 3072;
    const int pm = u.pm, pn = u.pn; const bool isctx = pm >= 64; const int b = isctx ? pm - 64 : pm >> 3;
    const int t0 = (isctx ? 0 : (pm & 7) * 256) + wr * 64 + fr;
    const int row0 = pm * 256 + wr * 64 + fr;
    const int kind = u.kind;
    if (kind == EK_Q || kind == EK_K) {
        const bool isq = kind == EK_Q; const LAS float* gp = EP.tab + 2048 + (isq ? 0 : 64); const int dbase = 32 * (fq >> 1) + 8 * (fq & 1), jb = 8 * (fq & 1);
        f32x4 gv[2][2];
#pragma unroll
        for (int bj = 0; bj < 2; ++bj)
#pragma unroll
            for (int n = 0; n < 2; ++n) gv[bj][n] = *(const LAS f32x4*)(gp + dbase + 16 * bj + 4 * n) * (isq ? C2 : 1.0f);
#pragma unroll
        for (int ai = 0; ai < 2; ++ai)
#pragma unroll
            for (int m = 0; m < 4; ++m) {
                float ss = 0.f;
#pragma unroll
                for (int bj = 0; bj < 2; ++bj)
#pragma unroll
                    for (int n = 0; n < 2; ++n) { const f32x4 x = acc[ai][bj][m][n]; ss += (x[0] * x[0] + x[1] * x[1]) + (x[2] * x[2] + x[3] * x[3]); }
                ss += __shfl_xor(ss, 16); ss += __shfl_xor(ss, 32);
                const float rs = __builtin_amdgcn_rsqf(ss * (1.0f / 64.0f) + EPS);
                f32x4 v[2][2];
#pragma unroll
                for (int bj = 0; bj < 2; ++bj)
#pragma unroll
                    for (int n = 0; n < 2; ++n) v[bj][n] = acc[ai][bj][m][n] * rs * gv[bj][n];
                const int t = t0 + 128 * ai + 16 * m;
                if (!isctx) {
                    const int pos = (fq >> 1) ? (t & 63) : (t >> 6);
                    const LAS float* cp = EP.tab + pos * 16 + jb; const LAS float* sp = EP.tab + 1024 + pos * 16 + jb;
#pragma unroll
                    for (int n = 0; n < 2; ++n) { const f32x4 cs = *(const LAS f32x4*)(cp + 4 * n), sn = *(const LAS f32x4*)(sp + 4 * n);
                        const f32x4 a = v[0][n], bb = v[1][n]; v[0][n] = a * cs - bb * sn; v[1][n] = bb * cs + a * sn; }
                }
                const int kk = (isctx ? 0 : CTXL) + t;
                bf16_t* dst = isq ? P.Q + (size_t)(row0 + 128 * ai + 16 * m) * DM + 256 * pn + 64 * wc + dbase
                                  : P.Kb + ((((size_t)(b * 4 + wc) * 36 + (kk >> 6)) * 8 + (dbase >> 3)) * 64 + (kk & 63)) * 8;
#pragma unroll
                for (int bj = 0; bj < 2; ++bj) *(u32x4*)(dst + (isq ? 16 : 1024) * bj) = pack8(v[bj][0], v[bj][1]);
                asm volatile("" ::: "memory");
            }
    } else if (kind == EK_V) {
#pragma unroll
        for (int ai = 0; ai < 2; ++ai)
#pragma unroll
            for (int m = 0; m < 4; ++m) { const int kk = (isctx ? 0 : CTXL) + t0 + 128 * ai + 16 * m;
#pragma unroll
                for (int bj = 0; bj < 2; ++bj) { bf16_t* dst = P.Vb + ((((size_t)(b * 4 + 2 * bj + (wc >> 1)) * 36 + (kk >> 6)) * 2 + (wc & 1)) * 64 + (kk & 63)) * 32 + 8 * fq;
                    *(u32x4*)dst = pack8(acc[ai][bj][m][0], acc[ai][bj][m][1]); } }
    } else if (kind == EK_ZA) {
#pragma unroll
        for (int ai = 0; ai < 2; ++ai)
#pragma unroll
            for (int m = 0; m < 4; ++m) { bf16_t* dst = P.SZA + (size_t)(row0 + 128 * ai + 16 * m) * DM + 256 * (pn - 6) + 32 * wc + 8 * fq;
#pragma unroll
                for (int bj = 0; bj < 2; ++bj) { f32x4 a = acc[ai][bj][m][0], c = acc[ai][bj][m][1];
#pragma unroll
                    for (int i = 0; i < 4; ++i) { a[i] = silu_ps(a[i]); c[i] = silu_ps(c[i]); }
                    *(u32x4*)(dst + 128 * bj) = pack8(a, c); } }
    } else if (kind == EK_XC) {
#pragma unroll
        for (int ai = 0; ai < 2; ++ai)
#pragma unroll
            for (int m = 0; m < 4; ++m) { bf16_t* dst = P.U + (size_t)(row0 + 128 * ai + 16 * m) * DM + 128 * (pn - 10) + 32 * wc + 8 * fq;
                *(u32x4*)dst = pack8(acc[ai][0][m][0] * acc[ai][1][m][0], acc[ai][0][m][1] * acc[ai][1][m][1]); }
    } else if (kind == EK_BZ) {
#pragma unroll
        for (int ai = 0; ai < 2; ++ai)
#pragma unroll
            for (int m = 0; m < 4; ++m) { bf16_t* dst = (isctx ? (bf16_t*)(ws + E_YZC) - (size_t)NLAT * DM : P.Wb) + (size_t)(row0 + 128 * ai + 16 * m) * DM + 128 * (pn - 18) + 32 * wc + 8 * fq;
                f32x4 a = acc[ai][1][m][0], c = acc[ai][1][m][1];
#pragma unroll
                for (int i = 0; i < 4; ++i) { a[i] = silu_ps(a[i]); c[i] = silu_ps(c[i]); }
                *(u32x4*)dst = pack8(acc[ai][0][m][0] * a, acc[ai][0][m][1] * c); }
    } else if (kind == EK_GL) {
        unsigned char* gb = g_rows(ws, EP.out, l, isctx, row0);
        const int col = 256 * (pn - 26) + 32 * wc + 8 * fq; const float qminf = pn >= 30 ? 1.0f : 0.0f;
        const float* bgp = ARGP(AR, I_BGATE, z) + l * 2048;
        f32x4 bv[2][2];
#pragma unroll
        for (int bj = 0; bj < 2; ++bj)
#pragma unroll
            for (int n = 0; n < 2; ++n) bv[bj][n] = *(const f32x4*)(bgp + col + 128 * bj + 4 * n) * -1.4426950408889634f;
        auto q4 = [&](const f32x4& x, const f32x4& bc) -> unsigned { float t[4];
#pragma unroll
            for (int i = 0; i < 4; ++i) { const float e = __builtin_amdgcn_exp2f(__builtin_fmaf(x[i], -1.4426950408889634f, bc[i]));
                const float r = __builtin_fmaxf(__builtin_amdgcn_rcpf(__builtin_fmaf(e, 1.0f / 255.0f, 1.0f / 255.0f)), qminf); t[i] = r + 8388608.0f; }
            return __builtin_amdgcn_perm(__float_as_uint(t[1]), __float_as_uint(t[0]), 0x0c0c0400u) | __builtin_amdgcn_perm(__float_as_uint(t[3]), __float_as_uint(t[2]), 0x04000c0cu); };
#pragma unroll
        for (int ai = 0; ai < 2; ++ai)
#pragma unroll
            for (int m = 0; m < 4; ++m) { unsigned char* dst = gb + (size_t)(128 * ai + 16 * m) * 2048 + col;
#pragma unroll
                for (int bj = 0; bj < 2; ++bj) { u32x2 w; w.x = q4(acc[ai][bj][m][0], bv[bj][0]); w.y = q4(acc[ai][bj][m][1], bv[bj][1]);
                    *(u32x2*)(dst + 128 * bj) = w; } }
    } else {
        const int col = 256 * pn + 32 * wc + 8 * fq; const float* gp = P.mod + (size_t)(isctx ? 8 : b) * 3072 + 2048 + col;
        f32x4 gv[2][2];
#pragma unroll
        for (int bj = 0; bj < 2; ++bj)
#pragma unroll
            for (int n = 0; n < 2; ++n) gv[bj][n] = *(const f32x4*)(gp + 128 * bj + 4 * n) * (1.0f / 255.0f);
        const bool rb16 = l && !isctx, wb16 = !l && !isctx;
        const bf16_t* X1B = (const bf16_t*)(ws + E_X1B) + (size_t)row0 * DM + col;
        const float* src = isctx ? ARGP(AR, I_CTX, z) + (size_t)(row0 - NLAT) * DM + col : ARGP(AR, I_X, z) + (size_t)row0 * DM + col;
        float* dst = isctx ? ctx1_half(ws, row0 - NLAT, pn >> 1) + (col & 511) : EP.out + (size_t)row0 * DM + col;
        const size_t dpitch = isctx ? 512 : DM;
        u32x4 xb[3][2][2];
#define OUT_LOAD(G) do { const size_t rn = (size_t)(128 * ((G) >> 2) + 16 * ((G) & 3)) * DM; \
            _Pragma("unroll") for (int bj = 0; bj < 2; ++bj) { \
                if (rb16) xb[(G) % 3][bj][0] = __builtin_nontemporal_load((const u32x4*)(X1B + rn + 128 * bj)); \
                else { _Pragma("unroll") for (int n = 0; n < 2; ++n) xb[(G) % 3][bj][n] = *(const u32x4*)(src + rn + 128 * bj + 4 * n); } } } while (0)
        OUT_LOAD(0); OUT_LOAD(1);
#pragma unroll
        for (int g = 0; g < 8; ++g) { const int ai = g >> 2, m = g & 3;
            if (g + 2 < 8) OUT_LOAD(g + 2);
#pragma unroll
            for (int bj = 0; bj < 2; ++bj) { f32x4 xa, xc; const u32x4 r0 = xb[g % 3][bj][0], r1 = xb[g % 3][bj][1];
                if (rb16) { xa = (f32x4){__uint_as_float(r0.x << 16), __uint_as_float(r0.x & 0xffff0000u), __uint_as_float(r0.y << 16), __uint_as_float(r0.y & 0xffff0000u)};
                            xc = (f32x4){__uint_as_float(r0.z << 16), __uint_as_float(r0.z & 0xffff0000u), __uint_as_float(r0.w << 16), __uint_as_float(r0.w & 0xffff0000u)}; }
                else { xa = __builtin_bit_cast(f32x4, r0); xc = __builtin_bit_cast(f32x4, r1); }
                xa = xa + gv[bj][0] * acc[ai][bj][m][0]; xc = xc + gv[bj][1] * acc[ai][bj][m][1];
                if (wb16) *(u32x4*)((bf16_t*)(ws + E_X1B) + (size_t)(row0 + 128 * ai + 16 * m) * DM + col + 128 * bj) = pack8(xa, xc);
                else { float* d = dst + (size_t)(128 * ai + 16 * m) * dpitch + 128 * bj; *(f32x4*)d = xa; *(f32x4*)(d + 4) = xc; } }
            asm volatile("" ::: "memory"); }
#undef OUT_LOAD
    }
}

__device__ __forceinline__ void chain_update(f32x4 (&acc)[2][2][4][2], const Unit& u, int wr, int wc, int fr, int fq, const EpiP& EP) {
    asm volatile("" : "+v"(fr), "+v"(fq));
    const bool br1 = u.kind == EK_BR1;
    const int pm = u.pm, pn = u.pn; const bool isctx = pm >= 64; const int row0 = pm * 256 + wr * 64 + fr;
    const unsigned char* gb = g_rows(EP.ws, EP.out, EP.l, isctx, row0);
    bf16_t* MRG = (bf16_t*)(EP.ws + E_HX);
    const int col = 256 * pn + 32 * wc + 8 * fq;
    u32x2 w1b[2][2], w0b[2][2];
#pragma unroll
    for (int bj = 0; bj < 2; ++bj) { w1b[0][bj] = *(const u32x2*)(gb + col + 1024 + 128 * bj); if (br1) w0b[0][bj] = *(const u32x2*)(gb + col + 128 * bj); else w0b[0][bj] = (u32x2){0u, 0u}; }
#pragma unroll
    for (int g = 0; g < 8; ++g) { const int ai = g >> 2, m = g & 3;
        if (g + 1 < 8) { const unsigned char* gn = gb + (size_t)(128 * ((g + 1) >> 2) + 16 * ((g + 1) & 3)) * 2048 + col;
#pragma unroll
            for (int bj = 0; bj < 2; ++bj) { w1b[(g + 1) & 1][bj] = *(const u32x2*)(gn + 1024 + 128 * bj); if (br1) w0b[(g + 1) & 1][bj] = *(const u32x2*)(gn + 128 * bj); else w0b[(g + 1) & 1][bj] = (u32x2){0u, 0u}; } }
#pragma unroll
        for (int bj = 0; bj < 2; ++bj) {
            const u32x2 w1 = w1b[g & 1][bj], w0 = w0b[g & 1][bj];
            const f32x4 g1a = {(float)(w1.x & 255u), (float)((w1.x >> 8) & 255u), (float)((w1.x >> 16) & 255u), (float)(w1.x >> 24)}, g1b = {(float)(w1.y & 255u), (float)((w1.y >> 8) & 255u), (float)((w1.y >> 16) & 255u), (float)(w1.y >> 24)};
            f32x4 ra, rb;
            if (br1) {
                const f32x4 g0a = {(float)(w0.x & 255u), (float)((w0.x >> 8) & 255u), (float)((w0.x >> 16) & 255u), (float)(w0.x >> 24)}, g0b = {(float)(w0.y & 255u), (float)((w0.y >> 8) & 255u), (float)((w0.y >> 16) & 255u), (float)(w0.y >> 24)};
#pragma unroll
                for (int i = 0; i < 4; ++i) { ra[i] = g0a[i] * __builtin_amdgcn_rcpf(g1a[i]); rb[i] = g0b[i] * __builtin_amdgcn_rcpf(g1b[i]); }
            } else {
                *(u32x4*)(MRG + (size_t)(row0 + 128 * ai + 16 * m) * DM + col + 128 * bj) = pack8(acc[ai][bj][m][0] * g1a, acc[ai][bj][m][1] * g1b);
                ra = rb = (f32x4){0.f, 0.f, 0.f, 0.f};
            }
            asm volatile("" : "+v"(ra), "+v"(rb));
            acc[ai][bj][m][0] = acc[ai][bj][m][0] * ra; acc[ai][bj][m][1] = acc[ai][bj][m][1] * rb;
            asm volatile("" : "+v"(acc[ai][bj][m][0]), "+v"(acc[ai][bj][m][1])); }
        asm volatile("" ::: "memory"); }
}

__device__ __forceinline__ void glds16_sb(const void* sbase, unsigned voff, unsigned lds_dst) {
    asm volatile("s_mov_b32 m0, %1\n\ts_nop 0\n\tglobal_load_lds_dwordx4 %0, %2" :: "v"(voff), "s"(lds_dst), "s"(sbase) : "memory", "m0"); }
template <bool CHAIN> __device__ __forceinline__ void gemm_phase(LAS unsigned char* lds, const GSched& S, const EpiP& E, const Args& AR, int tid) {
    const int wid = __builtin_amdgcn_readfirstlane(tid >> 6), lane = tid & 63, wr = wid >> 2, wc = wid & 3, fr = lane & 15, fq = lane >> 4;
    constexpr int K = KD, nt = K / BK;
    unsigned voffA[2];
#pragma unroll
    for (int i = 0; i < 2; ++i) { int R, C; stage_rc(tid * 16 + i * 8192, R, C); voffA[i] = (unsigned)(R * K + C) * 2u; }
    const size_t kstep = (size_t)(BK * 2);
    const size_t hstep = (size_t)HALF * K * 2;
    const unsigned ldsw = (unsigned)wid * 1024u;
    const int aoff = lds_byte(wr * 64 + fr, fq * 8), boff = lds_byte(wc * 32 + fr, fq * 8);
#define PG8_SA(b, h) (((b) * 2 + (h)) * HTB)
#define PG8_SB(b, h) ((4 + (b) * 2 + (h)) * HTB)
    const unsigned ldsb = (unsigned)(uintptr_t)lds;
#define PG8_STAGE(bufoff, gbase) do { _Pragma("unroll") for (int _i = 0; _i < 2; ++_i) glds16_sb((const char*)(gbase), voffA[_i], (unsigned)__builtin_amdgcn_readfirstlane(ldsb + (bufoff) + ldsw + _i * 8192)); } while (0)
#define PG8_LDA(dst, b, h) do { _Pragma("unroll") for (int m = 0; m < 4; ++m) _Pragma("unroll") for (int k = 0; k < 2; ++k) dst[m][k] = *(const LAS bf16x8*)(lds + PG8_SA(b, h) + aoff + m * 2048 + k * 1024); } while (0)
#define PG8_LDB(dst, b, h) do { _Pragma("unroll") for (int n = 0; n < 2; ++n) _Pragma("unroll") for (int k = 0; k < 2; ++k) dst[n][k] = *(const LAS bf16x8*)(lds + PG8_SB(b, h) + boff + n * 2048 + k * 1024); } while (0)
#define PG8_MMA(ai, bj, At, Bt) do { __builtin_amdgcn_s_setprio(1); _Pragma("unroll") for (int m = 0; m < 4; ++m) _Pragma("unroll") for (int n = 0; n < 2; ++n) _Pragma("unroll") for (int k = 0; k < 2; ++k) \
        acc[ai][bj][m][n] = __builtin_amdgcn_mfma_f32_16x16x32_bf16(Bt[n][k], At[m][k], acc[ai][bj][m][n], 0, 0, 0); __builtin_amdgcn_s_setprio(0); } while (0)
#define PG8_WAIT_V(n) asm volatile("s_waitcnt vmcnt(" #n ")" ::: "memory")
#define PG8_WAIT_L(n) asm volatile("s_waitcnt lgkmcnt(" #n ")" ::: "memory")
#define PG8_BAR __builtin_amdgcn_s_barrier()
#define PG8_SCHED __builtin_amdgcn_sched_barrier(0)
    Unit cur, nxt; int ui = 0;
    if (!S.next(0, cur)) return;
    f32x4 acc[2][2][4][2];
#pragma unroll
    for (int a = 0; a < 2; ++a)
#pragma unroll
        for (int b = 0; b < 2; ++b)
#pragma unroll
            for (int m = 0; m < 4; ++m)
#pragma unroll
                for (int n = 0; n < 2; ++n) acc[a][b][m][n] = (f32x4){0.f, 0.f, 0.f, 0.f};
    bf16x8 At[4][2], B0[2][2], B1[2][2];
    const char* cA = cur.A; const char* cB = cur.B;
    PG8_STAGE(PG8_SB(0, 0), cB); PG8_STAGE(PG8_SB(0, 1), cB + hstep); PG8_STAGE(PG8_SA(0, 0), cA); PG8_STAGE(PG8_SA(0, 1), cA + hstep);
    if (wr == 1) PG8_BAR;
    PG8_WAIT_V(2); PG8_BAR;
    PG8_STAGE(PG8_SB(1, 0), cB + kstep); PG8_STAGE(PG8_SA(1, 0), cA + kstep); PG8_STAGE(PG8_SB(1, 1), cB + hstep + kstep);
    PG8_WAIT_V(6); PG8_BAR;
    for (;;) {
        const bool has_next = S.next(ui + 1, nxt);
        const char* nA = has_next ? nxt.A : cA; const char* nB = has_next ? nxt.B : cB;
        for (int t = 0; t < nt; t += 2) {
            const bool last = (t == nt - 2);
            const char* a1 = cA + (size_t)(t + 1) * kstep;
            const char* a2 = last ? nA : cA + (size_t)(t + 2) * kstep; const char* b2 = last ? nB : cB + (size_t)(t + 2) * kstep;
            const char* a3 = a2 + kstep; const char* b3 = b2 + kstep;
            PG8_LDB(B0, 0, 0); PG8_LDB(B1, 0, 1); PG8_SCHED; PG8_LDA(At, 0, 0); PG8_STAGE(PG8_SA(1, 1), a1 + hstep);
            PG8_WAIT_V(8); PG8_WAIT_L(0); PG8_BAR; PG8_MMA(0, 0, At, B0); PG8_MMA(0, 1, At, B1); PG8_BAR; PG8_SCHED;
            PG8_LDA(At, 0, 1); PG8_STAGE(PG8_SB(0, 0), b2); PG8_STAGE(PG8_SB(0, 1), b2 + hstep); PG8_STAGE(PG8_SA(0, 0), a2);
            PG8_WAIT_V(8); PG8_WAIT_L(0); PG8_BAR; PG8_MMA(1, 0, At, B0); PG8_MMA(1, 1, At, B1); PG8_BAR; PG8_SCHED;
            PG8_LDB(B0, 1, 0); PG8_LDB(B1, 1, 1); PG8_SCHED; PG8_LDA(At, 1, 0); PG8_STAGE(PG8_SA(0, 1), a2 + hstep);
            PG8_WAIT_V(8); PG8_WAIT_L(0); PG8_BAR; PG8_MMA(0, 0, At, B0); PG8_MMA(0, 1, At, B1); PG8_BAR; PG8_SCHED;
            PG8_LDA(At, 1, 1); PG8_STAGE(PG8_SB(1, 0), b3); PG8_STAGE(PG8_SB(1, 1), b3 + hstep); PG8_STAGE(PG8_SA(1, 0), a3);
            PG8_WAIT_V(8); PG8_WAIT_L(0); PG8_BAR; PG8_MMA(1, 0, At, B0); PG8_MMA(1, 1, At, B1); PG8_BAR; PG8_SCHED;
        }
        if (wr == 0) PG8_BAR;
        if constexpr (CHAIN) chain_update(acc, cur, wr, wc, fr, fq, E);
        else {
            epilogue(acc, cur, wr, wc, fr, fq, E, AR);
#pragma unroll
            for (int a = 0; a < 2; ++a)
#pragma unroll
                for (int b = 0; b < 2; ++b)
#pragma unroll
                    for (int m = 0; m < 4; ++m)
#pragma unroll
                        for (int n = 0; n < 2; ++n) acc[a][b][m][n] = (f32x4){0.f, 0.f, 0.f, 0.f};
        }
        if (!has_next) break;
        cur = nxt; cA = nA; cB = nB; ++ui;
        if (wr == 1) PG8_BAR;
    }
    PG8_WAIT_V(0);
    PG8_BAR;
#undef PG8_SA
#undef PG8_SB
#undef PG8_STAGE
#undef PG8_LDA
#undef PG8_LDB
#undef PG8_MMA
#undef PG8_WAIT_V
#undef PG8_WAIT_L
#undef PG8_BAR
#undef PG8_SCHED
}
}
namespace attn_body {
using bf16=__hip_bfloat16;
using bf16x8=__attribute__((ext_vector_type(8)))short;
using s16x4=__attribute__((ext_vector_type(4)))short;
using f32x16=__attribute__((ext_vector_type(16)))float;
using u32x4=__attribute__((ext_vector_type(4)))unsigned;
constexpr int D=64,QP=1024,KP=256;
constexpr int NW=8,QBLK=32,QB=QBLK*NW,KVBLK=64;
__device__ __forceinline__ int crow(int r,int hi){return (r&3)+8*(r>>2)+4*hi;}
#define SBAR() __builtin_amdgcn_sched_barrier(0)
constexpr int NSLOT=3, SLOTB=8192;
constexpr int LDS_K=0, LDS_V=NSLOT*SLOTB, LDS_WS=2*NSLOT*SLOTB, LDS_OST=LDS_WS+NW*64*4, LDS_ZST=LDS_OST+NW*4096, LDS_BYTES=LDS_ZST+NW*4096;
__device__ __forceinline__ void glds16(const void*gsrc,unsigned lds_dst){unsigned keep;
  asm volatile("s_mov_b32 %0, m0\n\ts_mov_b32 m0, %2\n\ts_nop 0\n\tglobal_load_lds_dwordx4 %1, off\n\ts_mov_b32 m0, %0":"=&s"(keep):"v"(gsrc),"s"(lds_dst):"memory");}
__device__ __forceinline__ void glds16s(const void*sbase,unsigned voff,unsigned lds_dst){
  asm volatile("s_mov_b32 m0, %1\n\ts_nop 0\n\tglobal_load_lds_dwordx4 %0, %2"::"v"(voff),"s"(lds_dst),"s"(sbase):"memory","m0");}
__device__ __forceinline__ float max3f(float a,float b,float c){float r;asm("v_max3_f32 %0, %1, %2, %3":"=v"(r):"v"(a),"v"(b),"v"(c));return r;}
__device__ __forceinline__ float max2f(float a,float b){float r;asm("v_max_f32_e32 %0, %1, %2":"=v"(r):"v"(a),"v"(b));return r;}
__device__ __forceinline__ float fadd_s(float a,float b){float r;asm("v_add_f32_e32 %0, %1, %2":"=v"(r):"v"(a),"v"(b));return r;}
__device__ __forceinline__ float fsub_s(float a,float b){float r;asm("v_sub_f32_e32 %0, %1, %2":"=v"(r):"v"(a),"v"(b));return r;}
typedef float f32x2_t __attribute__((ext_vector_type(2))); typedef __bf16 bf16x2_t __attribute__((ext_vector_type(2)));
__device__ __forceinline__ unsigned cvtpk_s(float lo,float hi){f32x2_t v={lo,hi};bf16x2_t b=__builtin_convertvector(v,bf16x2_t);return __builtin_bit_cast(unsigned,b);}
#define WAIT_BAR(N) asm volatile("s_waitcnt vmcnt(" #N ") lgkmcnt(0)\n\ts_barrier":::"memory")

__device__ __forceinline__ void qkt(f32x16&p0,f32x16&p1,const char*Kslot,const bf16x8*qr,const f32x16&negm,int r32,int hi){
  const char*kb=Kslot+hi*1024+r32*16;
  #pragma unroll
  for(int d0=0;d0<4;++d0){
    const bf16x8 b0=*reinterpret_cast<const bf16x8*>(kb+d0*2048);
    const bf16x8 b1=*reinterpret_cast<const bf16x8*>(kb+d0*2048+512);
    if(d0==0){p0=__builtin_amdgcn_mfma_f32_32x32x16_bf16(b0,qr[0],negm,0,0,0);p1=__builtin_amdgcn_mfma_f32_32x32x16_bf16(b1,qr[0],negm,0,0,0);}
    else{p0=__builtin_amdgcn_mfma_f32_32x32x16_bf16(b0,qr[d0],p0,0,0,0);p1=__builtin_amdgcn_mfma_f32_32x32x16_bf16(b1,qr[d0],p1,0,0,0);}}
}
typedef __attribute__((address_space(3))) const char* lds_cptr;
typedef short v4i16_t __attribute__((ext_vector_type(4)));
__device__ __forceinline__ void kload8(bf16x8*kf,lds_cptr kp){
  kf[0]=*(const __attribute__((address_space(3))) bf16x8*)(kp);      kf[1]=*(const __attribute__((address_space(3))) bf16x8*)(kp+512);
  kf[2]=*(const __attribute__((address_space(3))) bf16x8*)(kp+2048); kf[3]=*(const __attribute__((address_space(3))) bf16x8*)(kp+2560);
  kf[4]=*(const __attribute__((address_space(3))) bf16x8*)(kp+4096); kf[5]=*(const __attribute__((address_space(3))) bf16x8*)(kp+4608);
  kf[6]=*(const __attribute__((address_space(3))) bf16x8*)(kp+6144); kf[7]=*(const __attribute__((address_space(3))) bf16x8*)(kp+6656);
}
__device__ __forceinline__ void kload2(bf16x8*kf,lds_cptr kp,int j){ kf[2*j]=*(const __attribute__((address_space(3))) bf16x8*)(kp+j*2048); kf[2*j+1]=*(const __attribute__((address_space(3))) bf16x8*)(kp+j*2048+512); }
__device__ __forceinline__ s16x4 vtr(lds_cptr p){ return __builtin_bit_cast(s16x4,__builtin_amdgcn_ds_read_tr16_b64_v4i16((__attribute__((address_space(3))) v4i16_t*)p)); }
__device__ __forceinline__ float rowmax(const f32x16&p0,const f32x16&p1){
  float a=max3f(p0[0],p0[1],p1[0]),b=max3f(p0[2],p0[3],p1[1]);a=max3f(a,p1[2],p1[3]);
  #pragma unroll
  for(int r=4;r<16;r+=4){a=max3f(a,p0[r],p0[r+1]);b=max3f(b,p0[r+2],p0[r+3]);a=max3f(a,p1[r],p1[r+1]);b=max3f(b,p1[r+2],p1[r+3]);}
  const float m=max2f(a,b);
  auto rr=__builtin_amdgcn_permlane32_swap(__float_as_uint(m),__float_as_uint(m),false,false);
  return max2f(__uint_as_float(rr[0]),__uint_as_float(rr[1]));
}
__device__ __forceinline__ void pv(f32x16*o,int vb,bf16x8 pa0,bf16x8 pa1,bf16x8 pa2,bf16x8 pa3){
  #pragma unroll
  for(int d0=0;d0<2;++d0){s16x4 lo[4],hi[4];
    #pragma unroll
    for(int ks=0;ks<4;++ks){
      asm volatile("ds_read_b64_tr_b16 %0,%1 offset:%c2":"=&v"(lo[ks]):"v"(vb),"i"(d0*4096+ks*1024):"memory");
      asm volatile("ds_read_b64_tr_b16 %0,%1 offset:%c2":"=&v"(hi[ks]):"v"(vb),"i"(d0*4096+ks*1024+512):"memory");}
    asm volatile("s_waitcnt lgkmcnt(0)":::"memory");SBAR();
    #define PK(k) (bf16x8){lo[k][0],lo[k][1],lo[k][2],lo[k][3],hi[k][0],hi[k][1],hi[k][2],hi[k][3]}
    o[d0]=__builtin_amdgcn_mfma_f32_32x32x16_bf16(pa0,PK(0),o[d0],0,0,0);
    o[d0]=__builtin_amdgcn_mfma_f32_32x32x16_bf16(pa1,PK(1),o[d0],0,0,0);
    o[d0]=__builtin_amdgcn_mfma_f32_32x32x16_bf16(pa2,PK(2),o[d0],0,0,0);
    o[d0]=__builtin_amdgcn_mfma_f32_32x32x16_bf16(pa3,PK(3),o[d0],0,0,0);
    #undef PK
  }
}

#ifndef ATTN_STORE16
#define ATTN_STORE16(p,v) (*(u32x4*)(p)=(v))
#endif
template<int THRL,bool NOMAX> __device__ __forceinline__ void attn_unit(long qrow0,int h,long krow0,int kvh,int NT,const bf16*Q,const bf16*__restrict__ K,const bf16*__restrict__ V,const bf16*__restrict__ SZ,bf16*O,char*shm,bool pre,long nk,long nq,bf16x8(&qc)[4]){
  int tid=threadIdx.x; asm volatile("":"+v"(tid)); const int lane=tid&63,r32=lane&31,hi=lane>>5; const int wid=__builtin_amdgcn_readfirstlane(tid>>6);
  const bf16*Qw=Q+(qrow0+wid*QBLK)*QP+h*D;
  const bf16*Kh=K+krow0*4096,*Vh=V+krow0*4096;
  const unsigned lds0=(unsigned)(uintptr_t)shm;
  float*wsf=(float*)(shm+LDS_WS)+wid*64;
  const unsigned kvoff=(unsigned)(wid*512+lane*8)*2u;
  const unsigned kdst=lds0+LDS_K+wid*1024, vdst=lds0+LDS_V+wid*1024;
  #define DMA_K(t,slot) glds16s(Kh+(long)(t)*4096,kvoff,(unsigned)__builtin_amdgcn_readfirstlane(kdst+(slot)))
  #define DMA_V(t,slot) glds16s(Vh+(long)(t)*4096,kvoff,(unsigned)__builtin_amdgcn_readfirstlane(vdst+(slot)))
  const int vb0=(int)(lds0+LDS_V)+((lane>>4)&1)*32+(lane&3)*8+(4*hi+((lane&15)>>2))*64;
  const char*Kbase=shm+LDS_K; bf16x8 kf[8];
  const lds_cptr shm3=(lds_cptr)shm; const lds_cptr kp0=shm3+LDS_K+hi*1024+r32*16; const lds_cptr vp0=shm3+LDS_V+((lane>>4)&1)*32+(lane&3)*8+(4*hi+((lane&15)>>2))*64;
  if(!pre){DMA_K(0,0);DMA_V(0,0);DMA_K(1,SLOTB);}
  bf16x8 qr[4];
  if(!pre){
    #pragma unroll
    for(int d0=0;d0<4;++d0)qr[d0]=*reinterpret_cast<const bf16x8*>(&Qw[(long)r32*QP+d0*16+hi*8]); }
  else{
    #pragma unroll
    for(int d0=0;d0<4;++d0)qr[d0]=qc[d0]; }
  float mhat=0.f,l_reg=0.f;
  typedef __attribute__((ext_vector_type(4))) float f32x4_t; f32x4_t lsum={0.f,0.f,0.f,0.f};
  const short one_=((((lane&15)<8)?0:1)==((lane>>4)&1))?(short)0x3F80:(short)0; bf16x8 onesA={one_,one_,one_,one_,one_,one_,one_,one_}; if constexpr(NOMAX)asm volatile("":"+v"(onesA));
  f32x16 o[2];o[0]=f32x16{};o[1]=f32x16{};f32x16 negm=f32x16{};if constexpr(!NOMAX)asm volatile("":"+v"(negm));
  #define CMASK(P0,P1,t) do{}while(0)
  bool resc=false;
  #define START(P0,P1) do{ resc=false; \
    if constexpr(!NOMAX){ const float rm=rowmax(P0,P1); const float dl=rm; mhat=fadd_s(mhat,dl); \
      _Pragma("unroll") for(int r=0;r<16;++r){P0[r]=fsub_s(P0[r],dl);P1[r]=fsub_s(P1[r],dl);} \
      _Pragma("unroll") for(int r=0;r<16;++r)negm[r]=-mhat; asm volatile("":"+v"(negm)); } \
    _Pragma("unroll") for(int r=0;r<16;++r)P0[r]=__builtin_amdgcn_exp2f(P0[r]); }while(0)
  #define RESC() do{ if constexpr(!NOMAX) if(resc){ asm volatile("s_waitcnt lgkmcnt(0)":::"memory"); \
      _Pragma("unroll") for(int d_=0;d_<2;++d_) _Pragma("unroll") for(int r=0;r<16;++r)o[d_][r]*=wsf[crow(r,hi)]; } }while(0)
  f32x16 pA0,pA1,pB0,pB1;
  int sl_prev=0,sl_cur=0,sl_next=SLOTB;
  #define ROT() do{sl_prev=sl_cur;sl_cur=sl_next;sl_next=(sl_next==(NSLOT-1)*SLOTB)?0:sl_next+SLOTB;}while(0)
  if(!pre){DMA_K(2,2*SLOTB);}
  if(pre){WAIT_BAR(4);}
  else{WAIT_BAR(3);}
  qkt(pA0,pA1,Kbase,qr,negm,r32,hi);asm volatile("s_nop 15\n\ts_nop 7":"+v"(pA0),"+v"(pA1));CMASK(pA0,pA1,0);
  START(pA0,pA1);
  _Pragma("unroll") for(int r=0;r<16;++r)pA1[r]=__builtin_amdgcn_exp2f(pA1[r]);
  WAIT_BAR(0);
  DMA_K(3,0);DMA_V(1,SLOTB);
  ROT();
  kload8(kf,kp0+sl_cur);
  WAIT_BAR(2);
  { const bf16*Zw=SZ+(qrow0+wid*QBLK)*QP+h*D;
    #pragma unroll
    for(int i=0;i<4;++i)glds16(Zw+(long)(i*8+(lane>>3))*QP+(lane&7)*8,(unsigned)__builtin_amdgcn_readfirstlane(lds0+LDS_ZST+wid*4096+i*1024)); }
  s16x4 vlo[8],vhi[8]; u32x4 pw0,pw1,pw2,pw3;
  #define PKW(P,B) cvtpk_s(P[B],P[B+1])
  #define PAF(k) __builtin_bit_cast(bf16x8,pw##k)
  #define VFR(i) (bf16x8){vlo[i][0],vlo[i][1],vlo[i][2],vlo[i][3],vhi[i][0],vhi[i][1],vhi[i][2],vhi[i][3]}
  #define PIN(x) asm volatile("":"+v"(x))
  #define MX3(a,b,c) __builtin_fmaxf(__builtin_fmaxf((a),(b)),(c))
  #define GAPA(MF,A0,A1,A2,A3,W0,W1,PW) do{ MF; if constexpr(!NOMAX){ sacc+=A0; sacc+=A1; sacc+=A2; sacc+=A3; PIN(sacc); } W0; W1; PIN(PW); SBAR(); }while(0)
  #define GAPA2(MF,A0,A1,W0,W1,PW) do{ MF; if constexpr(!NOMAX){ sacc+=A0; sacc+=A1; PIN(sacc); } W0; W1; PIN(PW); SBAR(); }while(0)
  #define LSUM(k) do{ if constexpr(NOMAX){ lsum=__builtin_amdgcn_mfma_f32_16x16x32_bf16(onesA,PAF(k),lsum,0,0,0); SBAR(); } }while(0)
  #define EX(v) __builtin_amdgcn_exp2f(v)
  #define GAPB(MF,X,B) do{ MF; X[B]=EX(X[B]); X[B+1]=EX(X[B+1]); X[B+2]=EX(X[B+2]); X[B+3]=EX(X[B+3]); PIN(X); SBAR(); }while(0)
  #define VRD(i) do{ vlo[i]=vtr(vp_+(((i)>>2)*4096+((i)&3)*1024)); vhi[i]=vtr(vp_+(((i)>>2)*4096+((i)&3)*1024+512)); }while(0)
  #define KRD(G,j) do{ if(G){ kload2(kf,kp0+sl_next,j); SBAR(); } }while(0)
  #define STEP(C0,C1,P0,P1,t,GK,GV,GL) do{ SBAR(); \
    const lds_cptr vp_=vp0+sl_prev; \
    VRD(0); SBAR(); float sacc=NOMAX?0.f:(P0[0]+P0[1]); \
    GAPA(C0=__builtin_amdgcn_mfma_f32_32x32x16_bf16(kf[0],qr[0],negm,0,0,0), P0[2],P0[3],P0[4],P0[5],     pw0[0]=PKW(P0,0), pw0[1]=PKW(P0,2), pw0); \
    VRD(4); SBAR(); GAPA(C1=__builtin_amdgcn_mfma_f32_32x32x16_bf16(kf[1],qr[0],negm,0,0,0), P0[6],P0[7],P0[8],P0[9],     pw0[2]=PKW(P0,4), pw0[3]=PKW(P0,6), pw0); \
    VRD(1); SBAR(); GAPA(C0=__builtin_amdgcn_mfma_f32_32x32x16_bf16(kf[2],qr[1],C0,0,0,0),   P0[10],P0[11],P0[12],P0[13], pw1[0]=PKW(P0,8), pw1[1]=PKW(P0,10), pw1); \
    VRD(5); SBAR(); GAPA(C1=__builtin_amdgcn_mfma_f32_32x32x16_bf16(kf[3],qr[1],C1,0,0,0),   P0[14],P0[15],P1[0],P1[1],   pw1[2]=PKW(P0,12),pw1[3]=PKW(P0,14), pw1); \
    VRD(2); SBAR(); GAPA(C0=__builtin_amdgcn_mfma_f32_32x32x16_bf16(kf[4],qr[2],C0,0,0,0),   P1[2],P1[3],P1[4],P1[5],     pw2[0]=PKW(P1,0), pw2[1]=PKW(P1,2), pw2); \
    VRD(6); SBAR(); GAPA(C1=__builtin_amdgcn_mfma_f32_32x32x16_bf16(kf[5],qr[2],C1,0,0,0),   P1[6],P1[7],P1[8],P1[9],     pw2[2]=PKW(P1,4), pw2[3]=PKW(P1,6), pw2); \
    VRD(3); SBAR(); GAPA(C0=__builtin_amdgcn_mfma_f32_32x32x16_bf16(kf[6],qr[3],C0,0,0,0),   P1[10],P1[11],P1[12],P1[13], pw3[0]=PKW(P1,8), pw3[1]=PKW(P1,10), pw3); \
    VRD(7); SBAR(); GAPA2(C1=__builtin_amdgcn_mfma_f32_32x32x16_bf16(kf[7],qr[3],C1,0,0,0),  P1[14],P1[15],               pw3[2]=PKW(P1,12),pw3[3]=PKW(P1,14), pw3); \
    if constexpr(!NOMAX) l_reg+=sacc; \
    if(GK){DMA_K((t)+3,sl_cur);} if(GV){DMA_V((t)+1,sl_next);} \
    CMASK(C0,C1,t); \
    if constexpr(!NOMAX){ float a=MX3(C0[0],C0[1],C1[0]),b=MX3(C0[2],C0[3],C1[1]); a=MX3(a,C1[2],C1[3]); \
      _Pragma("unroll") for(int r=4;r<16;r+=4){a=MX3(a,C0[r],C0[r+1]);b=MX3(b,C0[r+2],C0[r+3]);a=MX3(a,C1[r],C1[r+1]);b=MX3(b,C1[r+2],C1[r+3]);} \
      float rm=__builtin_fmaxf(a,b); { auto rr=__builtin_amdgcn_permlane32_swap(__float_as_uint(rm),__float_as_uint(rm),false,false); rm=__builtin_fmaxf(__uint_as_float(rr[0]),__uint_as_float(rr[1])); } \
      resc=false; \
      if(__builtin_expect(__any(rm>(float)THRL),0)){ const float dl=__builtin_fmaxf(rm,0.f); mhat+=dl; \
        _Pragma("unroll") for(int r=0;r<16;++r){C0[r]-=dl;C1[r]-=dl;} \
        _Pragma("unroll") for(int r=0;r<16;++r)negm[r]=-mhat; asm volatile("":"+v"(negm)); \
        const float f=__builtin_amdgcn_exp2f(-dl); l_reg*=f; if(hi==0)wsf[r32]=f; resc=true; } } \
    SBAR(); \
    GAPB(o[0]=__builtin_amdgcn_mfma_f32_32x32x16_bf16(PAF(0),VFR(0),o[0],0,0,0), C0,0); \
    GAPB(o[1]=__builtin_amdgcn_mfma_f32_32x32x16_bf16(PAF(0),VFR(4),o[1],0,0,0), C0,4); LSUM(0); \
    KRD(GL,0); GAPB(o[0]=__builtin_amdgcn_mfma_f32_32x32x16_bf16(PAF(1),VFR(1),o[0],0,0,0), C0,8); \
    KRD(GL,1); GAPB(o[1]=__builtin_amdgcn_mfma_f32_32x32x16_bf16(PAF(1),VFR(5),o[1],0,0,0), C0,12); LSUM(1); \
    KRD(GL,2); GAPB(o[0]=__builtin_amdgcn_mfma_f32_32x32x16_bf16(PAF(2),VFR(2),o[0],0,0,0), C1,0); \
    KRD(GL,3); GAPB(o[1]=__builtin_amdgcn_mfma_f32_32x32x16_bf16(PAF(2),VFR(6),o[1],0,0,0), C1,4); LSUM(2); \
    GAPB(o[0]=__builtin_amdgcn_mfma_f32_32x32x16_bf16(PAF(3),VFR(3),o[0],0,0,0), C1,8); \
    GAPB(o[1]=__builtin_amdgcn_mfma_f32_32x32x16_bf16(PAF(3),VFR(7),o[1],0,0,0), C1,12); LSUM(3); \
    }while(0)
  int t=1;
  #undef CMASK
  #define CMASK(P0,P1,t) do{}while(0)
  for(;t+5<NT;t+=2){
    STEP(pB0,pB1,pA0,pA1,t,true,true,true);     if(t==1){WAIT_BAR(6);}else{WAIT_BAR(2);} RESC(); ROT();
    STEP(pA0,pA1,pB0,pB1,t+1,true,true,true);   WAIT_BAR(2); RESC(); ROT();
  }
  #undef CMASK
  #define CMASK(P0,P1,t) do{}while(0)
  #define ENDW(tt) do{ if((tt)+3<NT){WAIT_BAR(2);} else if((tt)+2<NT){WAIT_BAR(1);} else {WAIT_BAR(0);} }while(0)
  for(;t+1<NT;t+=2){
    STEP(pB0,pB1,pA0,pA1,t,(t+3<NT),(t+1<NT),(t+1<NT));       ENDW(t);   RESC(); ROT();
    STEP(pA0,pA1,pB0,pB1,t+1,(t+4<NT),(t+2<NT),(t+2<NT));     ENDW(t+1); RESC(); ROT();
  }
  if(nk>=0){ const bf16*kn=K+nk*4096,*vn=V+nk*4096;
    glds16s(kn,kvoff,(unsigned)__builtin_amdgcn_readfirstlane(kdst)); glds16s(vn,kvoff,(unsigned)__builtin_amdgcn_readfirstlane(vdst)); glds16s(kn+4096,kvoff,(unsigned)__builtin_amdgcn_readfirstlane(kdst+SLOTB)); glds16s(kn+2*4096,kvoff,(unsigned)__builtin_amdgcn_readfirstlane(kdst+2*SLOTB));
    const bf16*Qn=Q+nq+(long)wid*QBLK*QP;
    #pragma unroll
    for(int d0=0;d0<4;++d0)qc[d0]=*reinterpret_cast<const bf16x8*>(&Qn[(long)r32*QP+d0*16+hi*8]); }
  STEP(pB0,pB1,pA0,pA1,NT-1,false,false,false); RESC();
  { if constexpr(!NOMAX){ float sacc=pB0[0]+pB0[1]; _Pragma("unroll") for(int r=2;r<16;++r)sacc+=pB0[r]; _Pragma("unroll") for(int r=0;r<16;++r)sacc+=pB1[r]; l_reg+=sacc; }
    pw0=(u32x4){PKW(pB0,0),PKW(pB0,2),PKW(pB0,4),PKW(pB0,6)};pw1=(u32x4){PKW(pB0,8),PKW(pB0,10),PKW(pB0,12),PKW(pB0,14)};pw2=(u32x4){PKW(pB1,0),PKW(pB1,2),PKW(pB1,4),PKW(pB1,6)};pw3=(u32x4){PKW(pB1,8),PKW(pB1,10),PKW(pB1,12),PKW(pB1,14)};
    SBAR(); pv(o,vb0+sl_cur,PAF(0),PAF(1),PAF(2),PAF(3)); LSUM(0); LSUM(1); LSUM(2); LSUM(3); }
  #undef PKW
  #undef PAF
  #undef VFR
  #undef PIN
  #undef MX3
  #undef GAPA
  #undef GAPA2
  #undef LSUM
  #undef GAPB
  #undef EX
  #undef VRD
  #undef KRD
  #undef STEP
  #undef ENDW
  if constexpr(NOMAX){ asm volatile("s_nop 7":"+v"(lsum)); if((lane&16)==0)wsf[32+(lane&15)+((lane>>5)<<4)]=lsum[0]; }
  else{ {auto rr=__builtin_amdgcn_permlane32_swap(__float_as_uint(l_reg),__float_as_uint(l_reg),false,false);l_reg=__uint_as_float(rr[0])+__uint_as_float(rr[1]);}
    if(hi==0)wsf[32+r32]=l_reg; }
  asm volatile("s_waitcnt lgkmcnt(0)":::"memory");
  float rli[16];
  #pragma unroll
  for(int r=0;r<16;++r)rli[r]=__builtin_amdgcn_rcpf(wsf[32+crow(r,hi)]);
  bf16*Ow=O+(qrow0+wid*QBLK)*QP+h*D;
  { bf16*stg=(bf16*)(shm+LDS_OST)+wid*2048; const bf16*zst=(const bf16*)(shm+LDS_ZST)+wid*2048;
    #pragma unroll
    for(int r=0;r<16;++r){const int orow=crow(r,hi);
      #pragma unroll
      for(int d0=0;d0<2;++d0)stg[orow*64+d0*32+r32]=__float2bfloat16(o[d0][r]*rli[r]);}
    asm volatile("s_waitcnt lgkmcnt(0)":::"memory");
    #pragma unroll
    for(int i=0;i<4;++i){const int row=i*8+(lane>>3),ch=lane&7; const u32x4 v=*(const u32x4*)(stg+row*64+ch*8); const u32x4 z=*(const u32x4*)(zst+row*64+ch*8); u32x4 w;
      #pragma unroll
      for(int e=0;e<4;++e){ const float lo=__uint_as_float(v[e]<<16)*__uint_as_float(z[e]<<16), hh=__uint_as_float(v[e]&0xffff0000u)*__uint_as_float(z[e]&0xffff0000u); w[e]=cvtpk_s(lo,hh); }
      ATTN_STORE16(Ow+(long)row*QP+ch*8,w);} }
  asm volatile("s_waitcnt lgkmcnt(0)\n\ts_barrier":::"memory");
  #undef DMA_K
  #undef DMA_V
  #undef CMASK
  #undef START
  #undef RESC
  #undef ROT
}
constexpr int ATTN_LDS_BYTES=LDS_BYTES;
#undef SBAR
#undef WAIT_BAR
}
constexpr size_t MiB = 1u << 20;
constexpr size_t WS_CTL = 0, CTL_ZERO_BYTES = 64 * 1024;
constexpr size_t WS_MOD = 1 * MiB;
constexpr size_t WS_ROPEC = WS_MOD + 256 * 1024, WS_ROPES = WS_ROPEC + 4096;
constexpr size_t WS_W = 2 * MiB, W_LAYER = 23 * MiB, W_IN = 0, W_A = 17 * MiB, W_C = 19 * MiB, W_O = 21 * MiB;
using pg8::e_k; using pg8::e_v; using pg8::e_sza; using pg8::e_u; using pg8::e_yz;
constexpr size_t WS_HX = pg8::E_HX, WS_Q = pg8::E_Q;
constexpr size_t WS_END = 264 * MiB;
__device__ __forceinline__ unsigned char* w_ptr(unsigned char* ws, int l, int which) { return which == 0 ? ws + WS_W + (size_t)l * W_LAYER : l ? ws + WS_W + W_LAYER + (17 + 2 * (which - 1)) * MiB : ws + (258 + 2 * (which - 1)) * MiB; }

constexpr int RING_OFF = 0, RING_BYTES = 131072;
constexpr int LDSCTL_OFF = RING_BYTES, MISC_OFF = LDSCTL_OFF + 320, EPI_TAB_OFF = LDSCTL_OFF + 1024;
constexpr int LDS_BYTES = 147456;
constexpr int NWAVES = 8;
constexpr int N_PHASES = 11;
constexpr int N_LAUNCHES = MK_N_LAUNCHES;
static_assert(N_LAUNCHES == 1 || N_LAUNCHES == N_PHASES, "MK_N_LAUNCHES is 1 or 11");

typedef GAS unsigned gu32;
#define RLX_AGENT __ATOMIC_RELAXED, __HIP_MEMORY_SCOPE_AGENT
#define LDS_WAIT() asm volatile("s_waitcnt lgkmcnt(0)" ::: "memory")
#define VM_WAIT() asm volatile("s_waitcnt vmcnt(0)" ::: "memory")

#define XB_TMO      128
#define XB_XCNT(j)  (256  + 64 * (j))
#define XB_XSUB(j)  (1280 + 64 * (j))
#define XB_XGEN(j)  (2304 + 64 * (j))
#define XB_TOP      3328
#define XB_TOPGEN   3392
#define XCD_BAR_WORDS 3456
#define XB_SPIN_CAP (1u << 18)

__device__ __forceinline__ unsigned xb_ld(unsigned* p)              { return __hip_atomic_load(p, __ATOMIC_RELAXED, __HIP_MEMORY_SCOPE_AGENT); }
__device__ __forceinline__ unsigned xb_add(unsigned* p, unsigned v) { return __hip_atomic_fetch_add(p, v, __ATOMIC_RELAXED, __HIP_MEMORY_SCOPE_AGENT); }
__device__ __forceinline__ unsigned xb_xcc_id() { return (unsigned)__builtin_amdgcn_s_getreg((3 << 11) | 20) & 0xFu; }
#define XB_SPIN(cond, bar) do { unsigned _sp = 0; while (cond) { __builtin_amdgcn_s_sleep(1); \
    if ((++_sp & 255u) == 0u) { if (xb_ld(&(bar)[XB_TMO])) break; if (_sp > XB_SPIN_CAP) { atomicAdd(&(bar)[XB_TMO], 1u); break; } } } } while (0)

struct XcdBarrier {
    unsigned* bar; unsigned x;
    volatile LAS unsigned* st;
};

__device__ __forceinline__ XcdBarrier xcd_barrier_post(unsigned* bar, volatile LAS unsigned* st) {
    XcdBarrier b; b.bar = bar; b.x = xb_xcc_id(); b.st = st;
    if (threadIdx.x == 0) (void)xb_add(&bar[XB_XCNT(b.x)], 1u);
    return b;
}
__device__ __forceinline__ void xcd_barrier_complete(unsigned* bar, unsigned x, unsigned& nloc, unsigned& nx) {
    const unsigned G = gridDim.x * gridDim.y * gridDim.z;
    unsigned sum, cnt, mine, sp = 0u;
    for (;;) {
        sum = 0u; cnt = 0u; mine = 0u;
#pragma unroll
        for (unsigned j = 0; j < 16; ++j) { const unsigned c = xb_ld(&bar[XB_XCNT(j)]); sum += c; cnt += (c > 0u) ? 1u : 0u; mine = (j == x) ? c : mine; }
        if (sum == G) break;
        __builtin_amdgcn_s_sleep(1);
        if ((++sp & 255u) == 0u) { if (xb_ld(&bar[XB_TMO])) break; if (sp > XB_SPIN_CAP) { atomicAdd(&bar[XB_TMO], 1u); break; } }
    }
    nloc = mine > 0u ? mine : 1u; nx = cnt > 0u ? cnt : 1u;
}

__device__ __forceinline__ void xcd_barrier(const XcdBarrier& b) {
    asm volatile("s_waitcnt vmcnt(0)" ::: "memory");
    __syncthreads();
    if (threadIdx.x == 0) {
        unsigned* bar = b.bar;
        __builtin_amdgcn_s_waitcnt(0);
        unsigned nloc = b.st[0], nx = b.st[1];
        if (nloc == 0u) { xcd_barrier_complete(bar, b.x, nloc, nx); b.st[0] = nloc; b.st[1] = nx; }
        const unsigned old = xb_add(&bar[XB_XSUB(b.x)], 1u);
        const unsigned gen = old / nloc;
        if (old + 1u == (gen + 1u) * nloc) {
            __builtin_amdgcn_fence(__ATOMIC_RELEASE, "agent");
            asm volatile("s_waitcnt vmcnt(0)" ::: "memory");
            const unsigned og = xb_add(&bar[XB_TOP], 1u);
            const unsigned tg = og / nx;
            if (og + 1u == (tg + 1u) * nx) xb_add(&bar[XB_TOPGEN], 1u);
            else XB_SPIN(xb_ld(&bar[XB_TOPGEN]) == tg, bar);
            __builtin_amdgcn_fence(__ATOMIC_ACQUIRE, "agent");
            xb_add(&bar[XB_XGEN(b.x)], 1u);
            asm volatile("s_waitcnt vmcnt(0)" ::: "memory");
        } else {
            XB_SPIN(xb_ld(&bar[XB_XGEN(b.x)]) == gen, bar);
            __builtin_amdgcn_fence(__ATOMIC_ACQUIRE, "agent");
            asm volatile("s_waitcnt vmcnt(0)" ::: "memory");
        }
    }
    __syncthreads();
}


constexpr int CW_BAR = 1024;
static_assert((CW_BAR + XCD_BAR_WORDS) * 4 <= (int)CTL_ZERO_BYTES, "control words inside the memset region");
static_assert(attn_body::ATTN_LDS_BYTES <= RING_BYTES, "attention scratch inside the ring region");


__device__ __forceinline__ float wave_max(float v) {
#pragma unroll
    for (int o = 1; o < 64; o <<= 1) v = fmaxf(v, __shfl_xor(v, o));
    return v;
}
__device__ __forceinline__ float wave_sum(float v) {
#pragma unroll
    for (int o = 1; o < 64; o <<= 1) v += __shfl_xor(v, o);
    return v;
}
__device__ __forceinline__ unsigned f2bf(float f) { unsigned u = __builtin_bit_cast(unsigned, f); return (u + 0x7fffu + ((u >> 16) & 1u)) >> 16; }
__device__ __forceinline__ unsigned pk2(float lo, float hi) { return f2bf(lo) | (f2bf(hi) << 16); }

__device__ __forceinline__ int wmap_sq(int n) { const int c = n & 255; return (n & ~255) + (c & 0xe0) + 8 * ((c >> 2) & 3) + 4 * ((c >> 4) & 1) + (c & 3); }
__device__ __forceinline__ int wmap_in(int n) {
    const int pn = n >> 8, c = n & 255, wc = (c >> 5) & 3, bj = c >> 7, nn = (c >> 4) & 1, fq = (c >> 2) & 3, i = c & 3;
    const int l8 = 8 * fq + 4 * nn + i, dd = 32 * (fq >> 1) + 8 * (fq & 1) + 16 * bj + 4 * nn + i;
    if (pn < 4) return 256 * pn + 64 * wc + dd;
    if (pn == 4) return 1024 + 64 * wc + dd;
    if (pn == 5) return 1280 + 128 * bj + 32 * wc + l8;
    if (pn < 10) return 1536 + 256 * (pn - 6) + 128 * bj + 32 * wc + l8;
    if (pn < 18) return (bj ? 4608 : 2560) + 128 * (pn - 10) + 32 * wc + l8;
    if (pn < 26) return (bj ? 5632 : 3584) + 128 * (pn - 18) + 32 * wc + l8;
    return 6656 + 256 * (pn - 26) + 128 * bj + 32 * wc + l8;
}
template <bool IN> __device__ __forceinline__ void transpose_item(const float* W, int N, bf16_t* WT, LAS float* scr, int item, int lane) {
    const int nblk = N / 32, kb = item / nblk, nb = item % nblk, k0 = 64 * kb, n0 = 32 * nb;
    const int jq = lane & 7, ks = lane >> 3; const int scol = IN ? wmap_in(n0 + 4 * jq) : wmap_sq(n0 + 4 * jq);
    f32x4 wv[8];
#pragma unroll
    for (int i = 0; i < 8; ++i) wv[i] = __builtin_nontemporal_load((const f32x4*)(W + (size_t)(k0 + 8 * i + ks) * N + scol));
    if (IN && ((scol >= 1536 && scol < 2560) || (scol >= 5632 && scol < 6656))) {
#pragma unroll
        for (int i = 0; i < 8; ++i) wv[i] = wv[i] * -1.4426950408889634f; }
    asm volatile("" ::: "memory");
#pragma unroll
    for (int i = 0; i < 8; ++i) { LAS float* d = scr + (8 * i + ks) * 33 + 4 * jq; d[0] = wv[i][0]; d[1] = wv[i][1]; d[2] = wv[i][2]; d[3] = wv[i][3]; }
    LDS_WAIT(); asm volatile("" ::: "memory");
    const int c = lane & 7;
#pragma unroll
    for (int j = 0; j < 4; ++j) { const int n = (lane >> 3) + 8 * j; const LAS float* s = scr + (8 * c) * 33 + n;
        u32x4 o; o.x = pk2(s[0 * 33], s[1 * 33]); o.y = pk2(s[2 * 33], s[3 * 33]); o.z = pk2(s[4 * 33], s[5 * 33]); o.w = pk2(s[6 * 33], s[7 * 33]);
        *(GAS u32x4*)(WT + (size_t)(n0 + n) * 1024 + k0 + 8 * c) = o; }
    LDS_WAIT(); asm volatile("" ::: "memory");
}

struct Frame {
    LAS unsigned char* lds; int tid, lane, wave, vcu, G;
    unsigned char* ws; int z;
};

#ifndef ATT_THR
#define ATT_THR 8
#endif
#ifndef TAIL_A
#define TAIL_A 3
#define TAIL_B 4
#endif
__device__ __forceinline__ void p0_prologue(Frame& F, const Args& A) {
    {
        LAS float* sc = (LAS float*)(F.lds + RING_OFF);
        LAS float* red = sc + 9 * 1024;
        bool have = false;
        for (int item = F.vcu; item < 256; item += F.G) {
            const int l = item >> 7, n0 = (item & 127) * 24;
            const int q = F.tid % 6, kg = F.tid / 6;
            f32x4 wv[16]; f32x4 a[9];
            if (F.tid < 384) { const float* w = ARGP(A, I_WADA, F.z) + (size_t)l * 1024 * 3072 + n0 + 4 * q;
#pragma unroll
                for (int i = 0; i < 16; ++i) wv[i] = __builtin_nontemporal_load((const f32x4*)(w + (size_t)(kg * 16 + i) * 3072)); }
            if (!have) { const float* cp = ARGP(A, I_C, F.z); const float* cc = ARGP(A, I_CCTX, F.z); float cv[18];
#pragma unroll
                for (int q2 = 0; q2 < 18; ++q2) { const int e = F.tid + q2 * (NWAVES * 64); cv[q2] = e < 8192 ? cp[e] : cc[e - 8192]; }
                asm volatile("" ::: "memory");
#pragma unroll
                for (int q2 = 0; q2 < 18; ++q2) sc[F.tid + q2 * (NWAVES * 64)] = silu_f(cv[q2]);
                have = true; __syncthreads(); }
            if (F.tid < 384) {
#pragma unroll
                for (int j = 0; j < 9; ++j) a[j] = (f32x4){0.f, 0.f, 0.f, 0.f};
                asm volatile("" ::: "memory");
#pragma unroll
                for (int i = 0; i < 16; ++i)
#pragma unroll
                    for (int j = 0; j < 9; ++j) a[j] += wv[i] * sc[j * 1024 + kg * 16 + i];
#pragma unroll
                for (int j = 0; j < 9; ++j) *(LAS f32x4*)(red + (kg * 9 + j) * 24 + 4 * q) = a[j]; }
            __syncthreads();
            if (F.tid < 216) { const int j = F.tid / 24, col = F.tid % 24; float s = ARGP(A, I_BADA, F.z)[l * 3072 + n0 + col];
#pragma unroll 8
                for (int g = 0; g < 64; ++g) s += red[(g * 9 + j) * 24 + col];
                ((float*)(F.ws + WS_MOD))[(size_t)(l * 9 + j) * 3072 + n0 + col] = s; }
            __syncthreads();
        }
    }
    if (F.vcu == F.G - 1) { for (int e = F.tid; e < 1024; e += NWAVES * 64) { const int pos = e >> 4, j = e & 15;
            const float inv = __builtin_amdgcn_exp2f(-(float)(2 * j) * (13.287712379549449f / 32.0f)), rev = (float)pos * inv * 0.15915494309189535f;
            ((float*)(F.ws + WS_ROPEC))[e] = __builtin_amdgcn_cosf(rev); ((float*)(F.ws + WS_ROPES))[e] = __builtin_amdgcn_sinf(rev); } }
}
__device__ __forceinline__ void weight_copies(Frame& F, const Args& A, int it_lo, int it_hi, int gw, int NGW) {
    LAS float* scr = (LAS float*)(F.lds + RING_OFF + F.wave * 16384);
    constexpr int I_IN = 16 * (PROJ / 32), I_SQ = 16 * 32, PER_L = I_IN + 3 * I_SQ;
    for (int it = it_lo + gw; it < it_hi; it += NGW) {
        const int l = it / PER_L; int r = it % PER_L;
        if (r < I_IN) { transpose_item<true>(ARGP(A, I_WIN, F.z) + (size_t)l * 1024 * PROJ, PROJ, (bf16_t*)w_ptr(F.ws, l, 0), scr, r, F.lane); continue; } r -= I_IN;
        if (r < I_SQ) { transpose_item<false>(ARGP(A, I_WABR, F.z) + (size_t)l * 1024 * 1024, 1024, (bf16_t*)w_ptr(F.ws, l, 1), scr, r, F.lane); continue; } r -= I_SQ;
        if (r < I_SQ) { transpose_item<false>(ARGP(A, I_WCBR, F.z) + (size_t)l * 1024 * 1024, 1024, (bf16_t*)w_ptr(F.ws, l, 2), scr, r, F.lane); continue; } r -= I_SQ;
        transpose_item<false>(ARGP(A, I_WOUT, F.z) + (size_t)l * 1024 * 1024, 1024, (bf16_t*)w_ptr(F.ws, l, 3), scr, r, F.lane);
    }
}
constexpr int WC_IN0 = 16 * (PROJ / 32), WC_ALL = 2 * (16 * (PROJ / 32) + 3 * 16 * 32);

__device__ __forceinline__ void modulate_phase(Frame& F, const Args& A, int l, const float* xs, int rlo, int rhi, int gw, int NGW) {
    const float* mod = (const float*)(F.ws + WS_MOD) + (size_t)l * 9 * 3072; const float* ng = ARGP(A, I_NORMG, F.z) + l * 1024;
    bf16_t* HX = (bf16_t*)(F.ws + WS_HX);
    const int R = (rhi - rlo + NGW - 1) / NGW; const int ra = rlo + gw * R; int rb = ra + R; if (rb > rhi) rb = rhi;
    f32x4 Gv[4], Sv[4]; int jcur = -1;
    for (int r0 = ra; r0 < rb; r0 += 2) {
        const bool two = r0 + 1 < rb; const int rr[2] = {r0, two ? r0 + 1 : r0};
        f32x4 v[2][4]; float s[2] = {0.f, 0.f}; u32x2 w16[2][4]; const bool b16 = l && r0 < NLAT;
#pragma unroll
        for (int u = 0; u < 2; ++u) { const int r = rr[u];
            if (b16) { const u32x2* xr = (const u32x2*)((const bf16_t*)(F.ws + pg8::E_X1B) + (size_t)r * DM) + F.lane;
#pragma unroll
                for (int q = 0; q < 4; ++q) w16[u][q] = __builtin_nontemporal_load(xr + 64 * q);
            } else if (r >= NLAT && l) {
#pragma unroll
                for (int q = 0; q < 4; ++q) v[u][q] = ((const f32x4*)pg8::ctx1_half(F.ws, r - NLAT, q >> 1))[F.lane + 64 * (q & 1)];
            } else { const float* xrow = r < NLAT ? xs + (size_t)r * DM : ARGP(A, I_CTX, F.z) + (size_t)(r - NLAT) * DM; const f32x4* xr = (const f32x4*)xrow + F.lane;
#pragma unroll
                for (int q = 0; q < 4; ++q) v[u][q] = __builtin_nontemporal_load(xr + 64 * q); } }
        asm volatile("" ::: "memory");
        if (b16) {
#pragma unroll
            for (int u = 0; u < 2; ++u)
#pragma unroll
                for (int q = 0; q < 4; ++q) v[u][q] = (f32x4){__uint_as_float(w16[u][q].x << 16), __uint_as_float(w16[u][q].x & 0xffff0000u), __uint_as_float(w16[u][q].y << 16), __uint_as_float(w16[u][q].y & 0xffff0000u)}; }
#pragma unroll
        for (int u = 0; u < 2; ++u)
#pragma unroll
            for (int q = 0; q < 4; ++q) s[u] += (v[u][q].x * v[u][q].x + v[u][q].y * v[u][q].y) + (v[u][q].z * v[u][q].z + v[u][q].w * v[u][q].w);
#pragma unroll
        for (int u = 0; u < 2; ++u) { if (u == 1 && !two) break; const int r = rr[u], j = r < NLAT ? (r >> 11) : 8;
            if (j != jcur) { jcur = j;
                const f32x4* sh = (const f32x4*)(mod + (size_t)j * 3072) + F.lane; const f32x4* scl = (const f32x4*)(mod + (size_t)j * 3072 + 1024) + F.lane; const f32x4* g4 = (const f32x4*)ng + F.lane;
#pragma unroll
                for (int q = 0; q < 4; ++q) { Gv[q] = g4[64 * q] * (scl[64 * q] + 1.0f); Sv[q] = sh[64 * q]; } }
            const float rstd = __builtin_amdgcn_rsqf(wave_sum(s[u]) * (1.0f / DM) + EPS);
            unsigned long long* o8 = (unsigned long long*)(HX + (size_t)r * DM) + F.lane;
#pragma unroll
            for (int q = 0; q < 4; ++q) { const f32x4 y = v[u][q] * rstd * Gv[q] + Sv[q];
                o8[64 * q] = (unsigned long long)cvt_pk_bf16(y.x, y.y) | ((unsigned long long)cvt_pk_bf16(y.z, y.w) << 32); } }
    }
}

__device__ __forceinline__ void conv_phase(Frame& F, const Args& A, int l, int nrows) {
    const bf16_t* U = (const bf16_t*)(F.ws + e_u(l)); bf16_t* YZL = (bf16_t*)(F.ws + e_yz(l)); bf16_t* YZC = (bf16_t*)(F.ws + pg8::E_YZC) - (size_t)NLAT * DM;
    const int ch = (F.tid & 127) * 8, rg = F.tid >> 7;
    const float* cw = ARGP(A, I_CONVW, F.z) + (size_t)l * 3 * 1024 + ch; const float* cb = ARGP(A, I_CONVB, F.z) + (size_t)l * 1024 + ch;
    float w0[8], w1[8], w2[8], bb[8];
#pragma unroll
    for (int e = 0; e < 8; ++e) { w0[e] = cw[e]; w1[e] = cw[1024 + e]; w2[e] = cw[2048 + e]; bb[e] = cb[e]; }
    const int nitems = (nrows + 71) / 72;
    for (int item = F.vcu; item < nitems; item += F.G) {
        const int r0 = item * 72 + rg * 18; int r1 = r0 + 18; if (r1 > nrows) r1 = nrows;
        if (r0 >= r1) continue;
        const u32x4 z4 = {0u, 0u, 0u, 0u};
        auto seqmask = [](int r) { return r < NLAT ? (SEQ - 1) : (CTXL - 1); };
        u32x4 up = ((r0 & seqmask(r0)) != 0) ? __builtin_nontemporal_load((const u32x4*)(U + (size_t)(r0 - 1) * DM + ch)) : z4;
        u32x4 uc = __builtin_nontemporal_load((const u32x4*)(U + (size_t)r0 * DM + ch));
        for (int rb = r0; rb < r1; rb += 6) {
            u32x4 un6[6], w6[6];
#pragma unroll
            for (int q = 0; q < 6; ++q) { const int r = rb + q; const bool ok = r < r1;
                un6[q] = (ok && r + 1 < NROW) ? __builtin_nontemporal_load((const u32x4*)(U + (size_t)(r + 1) * DM + ch)) : z4;
                w6[q] = ok ? __builtin_nontemporal_load((const u32x4*)((r < NLAT ? YZL : YZC) + (size_t)r * DM + ch)) : z4; }
            asm volatile("" ::: "memory");
#pragma unroll
            for (int q = 0; q < 6; ++q) { const int r = rb + q; if (r >= r1) break;
                const int sm = seqmask(r);
                const u32x4 unr = un6[q], un = ((r & sm) != sm) ? unr : z4, wv = w6[q];
                if ((r & sm) == 0) up = z4;
                u32x4 o;
#pragma unroll
                for (int e = 0; e < 4; ++e) {
                    const float ylo = bf_lo(wv[e]) * (w0[2 * e] * bf_lo(up[e]) + w1[2 * e] * bf_lo(uc[e]) + w2[2 * e] * bf_lo(un[e]) + bb[2 * e]);
                    const float yhi = bf_hi(wv[e]) * (w0[2 * e + 1] * bf_hi(up[e]) + w1[2 * e + 1] * bf_hi(uc[e]) + w2[2 * e + 1] * bf_hi(un[e]) + bb[2 * e + 1]);
                    o[e] = cvt_pk_bf16(ylo, yhi); }
                __builtin_nontemporal_store(o, (u32x4*)((r < NLAT ? YZL : YZC) + (size_t)r * DM + ch));
                up = uc; uc = unr; }
        }
    }
}

constexpr int CW_GRP = 8192;
__device__ __forceinline__ void group_sync(unsigned* ctl, int g, unsigned k) {
    asm volatile("s_waitcnt vmcnt(0)" ::: "memory");
    __syncthreads();
    if (threadIdx.x == 0) {
        unsigned* cnt = ctl + CW_GRP + 64 * g;
        __builtin_amdgcn_fence(__ATOMIC_RELEASE, "agent");
        asm volatile("s_waitcnt vmcnt(0)" ::: "memory");
        __hip_atomic_fetch_add(cnt, 1u, __ATOMIC_RELAXED, __HIP_MEMORY_SCOPE_AGENT);
        unsigned sp = 0;
        while (__hip_atomic_load(cnt, __ATOMIC_RELAXED, __HIP_MEMORY_SCOPE_AGENT) < 4u * k) { __builtin_amdgcn_s_sleep(2); if (++sp > (1u << 22)) break; }
        __builtin_amdgcn_fence(__ATOMIC_ACQUIRE, "agent");
        asm volatile("s_waitcnt vmcnt(0)" ::: "memory");
    }
    __syncthreads();
}

__global__ void __launch_bounds__(NWAVES * 64, 2) mk_fwd(Args args) {
    extern __shared__ __attribute__((aligned(16))) unsigned char lds[];
    { int t0 = threadIdx.x; for (int u = t0; u < (LDS_BYTES - LDSCTL_OFF) / 4; u += NWAVES * 64) ((LAS unsigned*)((LAS unsigned char*)lds + LDSCTL_OFF))[u] = 0u; }
    __syncthreads();
    XcdBarrier bar; bar.bar = (unsigned*)(args.ws + WS_CTL) + CW_BAR; bar.x = 0; bar.st = nullptr;
    if (N_LAUNCHES == 1) bar = xcd_barrier_post((unsigned*)(args.ws + WS_CTL) + CW_BAR, (volatile LAS unsigned*)((LAS unsigned char*)lds + MISC_OFF) + 8);

    int ph = args.ph_lo, sub = 0;
    while (ph < args.ph_hi) {
        int tid = threadIdx.x; asm volatile("" : "+v"(tid));
        size_t zoff = 0; asm volatile("" : "+s"(zoff));
        unsigned char* ws = args.ws + zoff; float* outp = args.out + zoff;
        Frame F; F.lds = (LAS unsigned char*)lds; F.tid = tid; F.lane = tid & 63; F.wave = __builtin_amdgcn_readfirstlane(tid >> 6);
        F.G = gridDim.x; { const int bx = blockIdx.x; F.vcu = (F.G % 8 == 0) ? (bx % 8) * (F.G / 8) + bx / 8 : bx; }
        F.ws = ws; F.z = 0; asm volatile("" : "+s"(F.z));
        const int c = (int)blockIdx.x, G = F.G; const int pl = ph >= 6 ? 1 : 0; const int plp = ph == 0 ? -1 : ph == 1 || ph == 6 ? 0 : (ph - (pl ? 7 : 2)) + 1;
        const bool tailph = (ph == 7), cx = tailph && c < 32; const int grp = c & 7, mem = c >> 3, cpm = 64 + grp;
        const bool tail = cx && sub < 3;
        const int lp = tail ? (sub == 0 ? 3 : sub == 1 ? 4 : 0) : plp;
        const int l = (tail && sub < 2) ? 0 : pl;
        const float* xs = ARGP(args, I_X, F.z);
        if (lp == -1) p0_prologue(F, args);
        else if (lp == 0) {
            if (tail) modulate_phase(F, args, 1, xs, NLAT + 256 * grp + 64 * mem, NLAT + 256 * grp + 64 * mem + 64, F.wave, NWAVES);
            else { if (!l) weight_copies(F, args, 0, WC_IN0, F.vcu * NWAVES + F.wave, F.G * NWAVES); modulate_phase(F, args, l, xs, 0, l ? NLAT : NROW, F.vcu * NWAVES + F.wave, F.G * NWAVES); }
        } else if (lp == 2) {
            const attn_body::bf16* Qp = (const attn_body::bf16*)(ws + WS_Q); const attn_body::bf16* Kp = (const attn_body::bf16*)(ws + e_k(l)); const attn_body::bf16* Vp = (const attn_body::bf16*)(ws + e_v(l));
            const attn_body::bf16* Zp = (const attn_body::bf16*)(ws + e_sza(l)); const int cslot = F.vcu & 3; int i = 0;
            bool fast; { const float gq = fabsf(ARGP(args, I_QNG, F.z)[l * 64 + F.lane]), gk = fabsf(ARGP(args, I_KNG, F.z)[l * 64 + F.lane]);
                fast = wave_max(gq) * wave_max(gk) * (0.18033688f * 64.0f * 1.02f) <= 60.0f; }
            bool pre = false; attn_body::bf16x8 qc[4];
#pragma unroll
            for (int d0 = 0; d0 < 4; ++d0) qc[d0] = (attn_body::bf16x8){0, 0, 0, 0, 0, 0, 0, 0};
            for (int id = F.vcu; id < 1024; id += F.G, ++i) { if (i == cslot) { conv_phase(F, args, l, l ? NLAT : NROW); }
                const int b = (id & 255) >> 5, h = 4 * (id >> 8) + ((id & 31) >> 3), qb = id & 7;
                const int idn = id + F.G; const bool pf = idn < 1024;
                const long nk = pf ? (long)((((idn & 255) >> 5) * 4 + (idn >> 8)) * 36) : -1;
                const long nq = ((long)((idn & 255) >> 5) * 2048 + (idn & 7) * 256) * 1024 + (4 * (idn >> 8) + ((idn & 31) >> 3)) * 64;
                if (fast) attn_body::attn_unit<ATT_THR, true>((long)b * 2048 + qb * 256, h, (long)(b * 4 + (h >> 2)) * 36, h >> 2, 36, Qp, Kp, Vp, Zp, (attn_body::bf16*)(ws + WS_Q), (char*)lds + RING_OFF, pre, nk, nq, qc);
                else attn_body::attn_unit<ATT_THR, false>((long)b * 2048 + qb * 256, h, (long)(b * 4 + (h >> 2)) * 36, h >> 2, 36, Qp, Kp, Vp, Zp, (attn_body::bf16*)(ws + WS_Q), (char*)lds + RING_OFF, pre, nk, nq, qc);
                pre = pf; }
            if (i <= cslot) { conv_phase(F, args, l, l ? NLAT : NROW); }
            if (!l) for (int id = F.vcu; id < 128; id += F.G) { const int b = id >> 4, h = id & 15;
                if (fast) attn_body::attn_unit<ATT_THR, true>((long)16384 + b * 256, h, (long)(b * 4 + (h >> 2)) * 36, h >> 2, 4, Qp, Kp, Vp, Zp, (attn_body::bf16*)(ws + WS_Q), (char*)lds + RING_OFF, false, -1, 0, qc);
                else attn_body::attn_unit<ATT_THR, false>((long)16384 + b * 256, h, (long)(b * 4 + (h >> 2)) * 36, h >> 2, 4, Qp, Kp, Vp, Zp, (attn_body::bf16*)(ws + WS_Q), (char*)lds + RING_OFF, false, -1, 0, qc); }
        } else {
            pg8::GSched S; S.base = c; S.stride = G; S.cnt = 1 << 20; S.xlast = -1; S.npre = 0; S.nx = 0; S.xpm = cpm; S.xpn = mem; S.xk0 = 0; S.xk1 = 0; S.A1 = nullptr; S.B1 = nullptr; S.pn0 = 0; S.nM = 64; S.nN = 4;
            pg8::EpiP E; E.ws = ws; E.out = outp; E.l = l; E.tab = (const LAS float*)((LAS unsigned char*)lds + EPI_TAB_OFF);
            if (lp == 1) {
                LAS float* tb = (LAS float*)((LAS unsigned char*)lds + EPI_TAB_OFF);
                { const f32x4 v = ((const f32x4*)(ws + WS_ROPEC))[tid & 255]; const f32x4 w = ((const f32x4*)(ws + WS_ROPES))[tid & 255]; if (tid < 256) ((LAS f32x4*)tb)[tid] = v; else ((LAS f32x4*)(tb + 1024))[tid - 256] = w; }
                if (tid < 32) ((LAS f32x4*)(tb + 2048))[tid] = tid < 16 ? ((const f32x4*)(ARGP(args, I_QNG, F.z) + l * 64))[tid] : ((const f32x4*)(ARGP(args, I_KNG, F.z) + l * 64))[tid - 16];
                __syncthreads(); }
            if (lp == 1) { S.mode = 0; S.nN = 34; S.nM = l ? 64 : 72; S.A0 = (const char*)(ws + WS_HX); S.B0 = (const char*)w_ptr(ws, l, 0);
                if (tailph) {
                    constexpr int TA = TAIL_A, TB = TAIL_B, TX = 160 - 16 * (TA + TB);
                    if (c >= 32) { S.base = c - 32; S.stride = G - 32; S.cnt = 9; if (c - 32 < TX) S.xlast = 2016 + (c - 32); }
                    else if (c < 16) { S.base = 2016 + TX + c; S.stride = 16; S.cnt = TA; S.npre = 1; S.xpn = 4 + mem; S.xk0 = mem ? pg8::EK_V : pg8::EK_K; }
                    else { S.base = 2016 + TX + 16 * TA + (c - 16); S.stride = 16; S.cnt = TB; } } }
            else if (lp == 3) { S.mode = 1; S.A0 = (const char*)(ws + WS_Q); S.B0 = (const char*)w_ptr(ws, l, 1); S.A1 = (const char*)(ws + e_yz(l)); S.B1 = (const char*)w_ptr(ws, l, 2);
                if (tail) { S.mode = 3; S.nx = 2; S.A0 += (size_t)cpm * pg8::TSTEP; S.B0 += (size_t)mem * pg8::TSTEP; S.A1 = (const char*)(ws + pg8::E_YZC) + (size_t)grp * pg8::TSTEP; S.B1 += (size_t)mem * pg8::TSTEP; S.xk0 = pg8::EK_BR1; S.xk1 = pg8::EK_BR2; } }
            else { S.mode = 2; S.A0 = (const char*)(ws + WS_HX); S.B0 = (const char*)w_ptr(ws, l, 3);
                if (tail) { S.mode = 3; S.nx = 1; S.A0 += (size_t)cpm * pg8::TSTEP; S.B0 += (size_t)mem * pg8::TSTEP; S.xk0 = pg8::EK_OUT; } }
            S.nwg = S.nM * S.nN;
            if (lp == 3) pg8::gemm_phase<true>(F.lds + RING_OFF, S, E, args, tid); else pg8::gemm_phase<false>(F.lds + RING_OFF, S, E, args, tid);
            if (lp == 1 && !l && G == 256 && c >= 144) weight_copies(F, args, WC_IN0, WC_ALL, (c - 144) * NWAVES + F.wave, 112 * NWAVES);
        }
        if (tail) { group_sync((unsigned*)(ws + WS_CTL), grp, (unsigned)(sub + 1)); ++sub; continue; }
        sub = 0;
        if (ph + 1 < args.ph_hi) { XcdBarrier b2 = bar; unsigned* bp = (unsigned*)(ws + WS_CTL) + CW_BAR; unsigned bx = bar.x; asm volatile("" : "+s"(bx)); b2.bar = bp; b2.x = bx; xcd_barrier(b2); }
        ++ph;
    }
}

extern "C" void kernel_launch(void* const* d_in, const int* in_sizes, int n_in, void* d_out, int out_size, void* d_ws, size_t ws_size, hipStream_t stream) {
    static int grid = 0;
    if (grid == 0) {
        if (n_in != 16 || in_sizes[0] != NLAT * DM || out_size != NLAT * DM || ws_size < WS_END) { fprintf(stderr, "kernel_launch: unexpected shapes / workspace (n_in %d, out %d, ws %zu); nothing launched\n", n_in, out_size, ws_size); grid = -1; return; }
        int dev = 0, cus = 0, per_cu = 0;
        if (hipGetDevice(&dev) != hipSuccess || hipDeviceGetAttribute(&cus, hipDeviceAttributeMultiprocessorCount, dev) != hipSuccess) { grid = -1; return; }
        if (hipFuncSetAttribute((const void*)mk_fwd, hipFuncAttributeMaxDynamicSharedMemorySize, LDS_BYTES) != hipSuccess) { fprintf(stderr, "kernel_launch: hipFuncSetAttribute failed\n"); grid = -1; return; }
        if (hipOccupancyMaxActiveBlocksPerMultiprocessor(&per_cu, (const void*)mk_fwd, NWAVES * 64, LDS_BYTES) != hipSuccess || per_cu < 1) { fprintf(stderr, "kernel_launch: occupancy query reports %d workgroups per CU\n", per_cu); (void)hipGetLastError(); grid = -1; return; }
        (void)hipGetLastError();
        if (cus != 256) { fprintf(stderr, "kernel_launch: built for a 256-CU device (the context tail's tile distribution), found %d\n", cus); grid = -1; return; }
        grid = cus;
    }
    if (grid < 0) return;
    if (hipMemsetAsync((char*)d_ws + WS_CTL, 0, CTL_ZERO_BYTES, stream) != hipSuccess) return;
    Args a{};
    for (int i = 0; i < 16; ++i) a.in[i] = (const float*)d_in[i];
    a.out = (float*)d_out; a.ws = (unsigned char*)d_ws;
    for (int li = 0; li < N_LAUNCHES; ++li) {
        a.ph_lo = (N_LAUNCHES == 1) ? 0 : li; a.ph_hi = (N_LAUNCHES == 1) ? N_PHASES : li + 1;
        hipLaunchKernelGGL(mk_fwd, dim3(grid), dim3(NWAVES * 64), LDS_BYTES, stream, a);
    }
}
```

```cpp
#include <hip/hip_runtime.h>
#include <hip/hip_bf16.h>
#include <cstdio>
#include <cstdint>

#define MK_N_LAUNCHES 1
#ifndef MK_N_LAUNCHES
#define MK_N_LAUNCHES 1
#endif

constexpr int DM = 1024, NBATCH = 8, SEQ = 2048, CTXL = 256, NLAT = NBATCH * SEQ, NCTX = NBATCH * CTXL, NROW = NLAT + NCTX;
constexpr int PROJ = 8704, KVLEN = CTXL + SEQ, KVP = 256;
constexpr float EPS = 1e-6f;
constexpr float C2 = 0.125f * 1.4426950408889634f;

struct Args { const float* in[16]; float* out; unsigned char* ws; int ph_lo, ph_hi; };
enum In { I_X = 0, I_C, I_CTX, I_CCTX, I_NORMG, I_WADA, I_BADA, I_WIN, I_QNG, I_KNG, I_CONVW, I_CONVB, I_WABR, I_WCBR, I_BGATE, I_WOUT };
#define ARGP(A, i, z) (((const __attribute__((address_space(4))) Args*)__builtin_amdgcn_kernarg_segment_ptr())->in[(i) + (z)])

#define LAS __attribute__((address_space(3)))
#define GAS __attribute__((address_space(1)))
typedef unsigned short bf16_t;
typedef short bf16x8 __attribute__((ext_vector_type(8)));
typedef float f32x4 __attribute__((ext_vector_type(4)));
typedef unsigned u32x4 __attribute__((ext_vector_type(4)));
typedef unsigned u32x2 __attribute__((ext_vector_type(2)));

typedef float f32x2_c __attribute__((ext_vector_type(2))); typedef __bf16 bf16x2_c __attribute__((ext_vector_type(2)));
__device__ __forceinline__ unsigned cvt_pk_bf16(float lo, float hi) { f32x2_c v = {lo, hi}; bf16x2_c b = __builtin_convertvector(v, bf16x2_c); return __builtin_bit_cast(unsigned, b); }
__device__ __forceinline__ float bf_lo(unsigned w) { return __uint_as_float(w << 16); }
__device__ __forceinline__ float bf_hi(unsigned w) { return __uint_as_float(w & 0xffff0000u); }
__device__ __forceinline__ float sigmoid_f(float x) { return __builtin_amdgcn_rcpf(1.0f + __expf(-x)); }
__device__ __forceinline__ float silu_f(float x) { return x * sigmoid_f(x); }
__device__ __forceinline__ float silu_ps(float a) { const float e = __builtin_amdgcn_exp2f(a); return a * __builtin_amdgcn_rcpf(__builtin_fmaf(e, -1.4426950408889634f, -1.4426950408889634f)); }
__device__ __forceinline__ u32x4 pack8(const f32x4& a, const f32x4& b) { u32x4 w; w.x = cvt_pk_bf16(a[0], a[1]); w.y = cvt_pk_bf16(a[2], a[3]); w.z = cvt_pk_bf16(b[0], b[1]); w.w = cvt_pk_bf16(b[2], b[3]); return w; }

namespace pg8 {
constexpr int BM = 256, BK = 64, HALF = 128, HTB = HALF * BK * 2, STAGE_BYTES = 8 * HTB, NXCD = 8, WGM = 3, KD = 1024;
constexpr size_t TSTEP = (size_t)BM * KD * 2;
__host__ __device__ __forceinline__ int lds_byte(int r, int c) { const int st = (r >> 4) * 2 + (c >> 5), rr = r & 15, cc = c & 31, ob = rr * 64 + cc * 2; return st * 1024 + (ob ^ (((ob >> 9) & 1) << 5)); }
__host__ __device__ __forceinline__ void stage_rc(int b, int& R, int& C) { const int st = b / 1024, sb = b % 1024, swz = sb ^ (((sb >> 9) & 1) << 5); R = (st >> 1) * 16 + swz / 64; C = (st & 1) * 32 + (swz % 64) / 2; }

struct Unit { const char* A; const char* B; int pm, pn, kind, chain; };

enum Kind { EK_Q = 0, EK_K = 1, EK_V = 2, EK_ZA = 3, EK_XC = 4, EK_BZ = 5, EK_GL = 6, EK_BR1 = 7, EK_BR2 = 8, EK_OUT = 9 };

struct GSched {
    int base, stride, cnt, xlast, npre;
    int mode  , nM, nN, pn0, nwg, nx, xpm, xpn, xk0, xk1;
    const char *A0, *A1, *B0, *B1;
    __device__ __forceinline__ bool next(int i, Unit& u) const {
        if (mode == 3) { if (i >= nx) return false; u.A = i ? A1 : A0; u.B = i ? B1 : B0; u.pm = xpm; u.pn = xpn; u.kind = i ? xk1 : xk0; u.chain = (nx == 2 && i == 0) ? 1 : 0; return true; }
        if (i < npre) { u.A = A0 + (size_t)xpm * TSTEP; u.B = B0 + (size_t)xpn * TSTEP; u.pm = xpm; u.pn = xpn; u.kind = xk0; u.chain = 0; return true; }
        i -= npre;
        const int ti = (mode == 1) ? (i >> 1) : i, seg = (mode == 1) ? (i & 1) : 0;
        if (ti > cnt || (ti == cnt && xlast < 0)) return false;
        const long L = ti == cnt ? (long)xlast : (long)base + (long)ti * stride; int pm, pn;
        if (L >= nwg) return false;
        {
            int wgid = (int)L; { const int q = nwg / NXCD, r = nwg % NXCD, xcd = wgid % NXCD, off = wgid / NXCD; wgid = (xcd < r ? xcd * (q + 1) : r * (q + 1) + (xcd - r) * q) + off; }
            static_assert(WGM == 3, "the tile order below is written for groups of three panels");
            int gid, rem; if (mode == 0) { gid = wgid / (3 * 34); rem = wgid - gid * (3 * 34); } else { gid = wgid / (3 * 4); rem = wgid - gid * (3 * 4); }
            const int fm = gid * 3, gsz = (nM - fm) < 3 ? (nM - fm) : 3;
            const int q3 = gsz == 3 ? rem / 3 : gsz == 2 ? (rem >> 1) : rem;
            pm = fm + (rem - q3 * gsz); pn = pn0 + q3;
        }
        u.pm = pm; u.pn = pn;
        if (mode == 0) { u.A = A0 + (size_t)pm * TSTEP; u.B = B0 + (size_t)pn * TSTEP; u.chain = 0;
            u.kind = pn < 4 ? EK_Q : pn == 4 ? EK_K : pn == 5 ? EK_V : pn < 10 ? EK_ZA : pn < 18 ? EK_XC : pn < 26 ? EK_BZ : EK_GL; }
        else if (mode == 1) { u.A = (seg ? A1 : A0) + (size_t)pm * TSTEP; u.B = (seg ? B1 : B0) + (size_t)pn * TSTEP; u.kind = seg ? EK_BR2 : EK_BR1; u.chain = seg ? 0 : 1; }
        else { u.A = A0 + (size_t)pm * TSTEP; u.B = B0 + (size_t)pn * TSTEP; u.kind = EK_OUT; u.chain = 0; }
        return true;
    }
};

struct EpiP { unsigned char* ws; float* out; int l; const LAS float* tab; };
constexpr size_t EMiB = 1u << 20;
constexpr size_t E_MOD = 1 * EMiB, E_ROPEC = E_MOD + 256 * 1024, E_ROPES = E_ROPEC + 4096, E_HX = 48 * EMiB, E_Q = 84 * EMiB;
__device__ __forceinline__ size_t e_k(int l) { return l ? 2 * EMiB : 120 * EMiB; }
__device__ __forceinline__ size_t e_v(int l) { return l ? 11 * EMiB : 129 * EMiB; }
__device__ __forceinline__ size_t e_sza(int l) { return l ? 120 * EMiB : 138 * EMiB; }
__device__ __forceinline__ size_t e_u(int l) { return l ? 152 * EMiB : 174 * EMiB; }
__device__ __forceinline__ size_t e_yz(int l) { return l ? 184 * EMiB : 210 * EMiB; }
constexpr size_t E_GCTX = 254 * EMiB, E_X1B = 216 * EMiB, E_YZC = 250 * EMiB;
__device__ __forceinline__ float* ctx1_half(unsigned char* ws, int r, int h) { return (float*)(ws + (h ? E_GCTX : E_YZC) + (size_t)r * 2048); }
__device__ __forceinline__ unsigned char* g_rows(unsigned char* ws, float* out, int l, bool isctx, int row0) {
    return isctx ? ws + E_GCTX + (size_t)(row0 - NLAT) * 2048 : (unsigned char*)out + (size_t)row0 * 2048; }
__device__ __forceinline__ unsigned q8(float g, unsigned qmin) { unsigned q = (unsigned)(g * 255.0f + 0.5f); return q < qmin ? qmin : q; }
__device__ __forceinline__ void epilogue(const f32x4 (&acc)[2][2][4][2], const Unit& u, int wr, int wc, int fr, int fq, const EpiP& EP, const Args& AR) {
    int z = 0; asm volatile("" : "+v"(fr), "+v"(fq), "+s"(z));
    unsigned char* const ws = EP.ws; const int l = EP.l;
    struct { bf16_t *Q, *Kb, *Vb, *SZA, *U, *Wb; const float *ropec, *ropes, *mod; } P;
    P.Q = (bf16_t*)(ws + E_Q); P.Kb = (bf16_t*)(ws + e_k(l)); P.Vb = (bf16_t*)(ws + e_v(l)); P.SZA = (bf16_t*)(ws + e_sza(l)); P.U = (bf16_t*)(ws + e_u(l)); P.Wb = (bf16_t*)(ws + e_yz(l));
    P.ropec = (const float*)(ws + E_ROPEC); P.ropes = (const float*)(ws + E_ROPES); P.mod = (const float*)(ws + E_MOD) + (size_t)l * 9 * 3072;
    const int pm = u.pm, pn = u.pn; const bool isctx = pm >= 64; const int b = isctx ? pm - 64 : pm >> 3;
    const int t0 = (isctx ? 0 : (pm & 7) * 256) + wr * 64 + fr;
    const int row0 = pm * 256 + wr * 64 + fr;
    const int kind = u.kind;
    if (kind == EK_Q || kind == EK_K) {
        const bool isq = kind == EK_Q; const LAS float* gp = EP.tab + 2048 + (isq ? 0 : 64); const int dbase = 32 * (fq >> 1) + 8 * (fq & 1), jb = 8 * (fq & 1);
        f32x4 gv[2][2];
#pragma unroll
        for (int bj = 0; bj < 2; ++bj)
#pragma unroll
            for (int n = 0; n < 2; ++n) gv[bj][n] = *(const LAS f32x4*)(gp + dbase + 16 * bj + 4 * n) * (isq ? C2 : 1.0f);
#pragma unroll
        for (int ai = 0; ai < 2; ++ai)
#pragma unroll
            for (int m = 0; m < 4; ++m) {
                float ss = 0.f;
#pragma unroll
                for (int bj = 0; bj < 2; ++bj)
#pragma unroll
                    for (int n = 0; n < 2; ++n) { const f32x4 x = acc[ai][bj][m][n]; ss += (x[0] * x[0] + x[1] * x[1]) + (x[2] * x[2] + x[3] * x[3]); }
                ss += __shfl_xor(ss, 16); ss += __shfl_xor(ss, 32);
                const float rs = __builtin_amdgcn_rsqf(ss * (1.0f / 64.0f) + EPS);
                f32x4 v[2][2];
#pragma unroll
                for (int bj = 0; bj < 2; ++bj)
#pragma unroll
                    for (int n = 0; n < 2; ++n) v[bj][n] = acc[ai][bj][m][n] * rs * gv[bj][n];
                const int t = t0 + 128 * ai + 16 * m;
                if (!isctx) {
                    const int pos = (fq >> 1) ? (t & 63) : (t >> 6);
                    const LAS float* cp = EP.tab + pos * 16 + jb; const LAS float* sp = EP.tab + 1024 + pos * 16 + jb;
#pragma unroll
                    for (int n = 0; n < 2; ++n) { const f32x4 cs = *(const LAS f32x4*)(cp + 4 * n), sn = *(const LAS f32x4*)(sp + 4 * n);
                        const f32x4 a = v[0][n], bb = v[1][n]; v[0][n] = a * cs - bb * sn; v[1][n] = bb * cs + a * sn; }
                }
                const int kk = (isctx ? 0 : CTXL) + t;
                bf16_t* dst = isq ? P.Q + (size_t)(row0 + 128 * ai + 16 * m) * DM + 256 * pn + 64 * wc + dbase
                                  : P.Kb + ((((size_t)(b * 4 + wc) * 36 + (kk >> 6)) * 8 + (dbase >> 3)) * 64 + (kk & 63)) * 8;
#pragma unroll
                for (int bj = 0; bj < 2; ++bj) *(u32x4*)(dst + (isq ? 16 : 1024) * bj) = pack8(v[bj][0], v[bj][1]);
                asm volatile("" ::: "memory");
            }
    } else if (kind == EK_V) {
#pragma unroll
        for (int ai = 0; ai < 2; ++ai)
#pragma unroll
            for (int m = 0; m < 4; ++m) { const int kk = (isctx ? 0 : CTXL) + t0 + 128 * ai + 16 * m;
#pragma unroll
                for (int bj = 0; bj < 2; ++bj) { bf16_t* dst = P.Vb + ((((size_t)(b * 4 + 2 * bj + (wc >> 1)) * 36 + (kk >> 6)) * 2 + (wc & 1)) * 64 + (kk & 63)) * 32 + 8 * fq;
                    *(u32x4*)dst = pack8(acc[ai][bj][m][0], acc[ai][bj][m][1]); } }
    } else if (kind == EK_ZA) {
#pragma unroll
        for (int ai = 0; ai < 2; ++ai)
#pragma unroll
            for (int m = 0; m < 4; ++m) { bf16_t* dst = P.SZA + (size_t)(row0 + 128 * ai + 16 * m) * DM + 256 * (pn - 6) + 32 * wc + 8 * fq;
#pragma unroll
                for (int bj = 0; bj < 2; ++bj) { f32x4 a = acc[ai][bj][m][0], c = acc[ai][bj][m][1];
#pragma unroll
                    for (int i = 0; i < 4; ++i) { a[i] = silu_ps(a[i]); c[i] = silu_ps(c[i]); }
                    *(u32x4*)(dst + 128 * bj) = pack8(a, c); } }
    } else if (kind == EK_XC) {
#pragma unroll
        for (int ai = 0; ai < 2; ++ai)
#pragma unroll
            for (int m = 0; m < 4; ++m) { bf16_t* dst = P.U + (size_t)(row0 + 128 * ai + 16 * m) * DM + 128 * (pn - 10) + 32 * wc + 8 * fq;
                *(u32x4*)dst = pack8(acc[ai][0][m][0] * acc[ai][1][m][0], acc[ai][0][m][1] * acc[ai][1][m][1]); }
    } else if (kind == EK_BZ) {
#pragma unroll
        for (int ai = 0; ai < 2; ++ai)
#pragma unroll
            for (int m = 0; m < 4; ++m) { bf16_t* dst = (isctx ? (bf16_t*)(ws + E_YZC) - (size_t)NLAT * DM : P.Wb) + (size_t)(row0 + 128 * ai + 16 * m) * DM + 128 * (pn - 18) + 32 * wc + 8 * fq;
                f32x4 a = acc[ai][1][m][0], c = acc[ai][1][m][1];
#pragma unroll
                for (int i = 0; i < 4; ++i) { a[i] = silu_ps(a[i]); c[i] = silu_ps(c[i]); }
                *(u32x4*)dst = pack8(acc[ai][0][m][0] * a, acc[ai][0][m][1] * c); }
    } else if (kind == EK_GL) {
        unsigned char* gb = g_rows(ws, EP.out, l, isctx, row0);
        const int col = 256 * (pn - 26) + 32 * wc + 8 * fq; const float qminf = pn >= 30 ? 1.0f : 0.0f;
        const float* bgp = ARGP(AR, I_BGATE, z) + l * 2048;
        f32x4 bv[2][2];
#pragma unroll
        for (int bj = 0; bj < 2; ++bj)
#pragma unroll
            for (int n = 0; n < 2; ++n) bv[bj][n] = *(const f32x4*)(bgp + col + 128 * bj + 4 * n) * -1.4426950408889634f;
        auto q4 = [&](const f32x4& x, const f32x4& bc) -> unsigned { float t[4];
#pragma unroll
            for (int i = 0; i < 4; ++i) { const float e = __builtin_amdgcn_exp2f(__builtin_fmaf(x[i], -1.4426950408889634f, bc[i]));
                const float r = __builtin_fmaxf(__builtin_amdgcn_rcpf(__builtin_fmaf(e, 1.0f / 255.0f, 1.0f / 255.0f)), qminf); t[i] = r + 8388608.0f; }
            return __builtin_amdgcn_perm(__float_as_uint(t[1]), __float_as_uint(t[0]), 0x0c0c0400u) | __builtin_amdgcn_perm(__float_as_uint(t[3]), __float_as_uint(t[2]), 0x04000c0cu); };
#pragma unroll
        for (int ai = 0; ai < 2; ++ai)
#pragma unroll
            for (int m = 0; m < 4; ++m) { unsigned char* dst = gb + (size_t)(128 * ai + 16 * m) * 2048 + col;
#pragma unroll
                for (int bj = 0; bj < 2; ++bj) { u32x2 w; w.x = q4(acc[ai][bj][m][0], bv[bj][0]); w.y = q4(acc[ai][bj][m][1], bv[bj][1]);
                    *(u32x2*)(dst + 128 * bj) = w; } }
    } else {
        const int col = 256 * pn + 32 * wc + 8 * fq; const float* gp = P.mod + (size_t)(isctx ? 8 : b) * 3072 + 2048 + col;
        f32x4 gv[2][2];
#pragma unroll
        for (int bj = 0; bj < 2; ++bj)
#pragma unroll
            for (int n = 0; n < 2; ++n) gv[bj][n] = *(const f32x4*)(gp + 128 * bj + 4 * n) * (1.0f / 255.0f);
        const bool rb16 = l && !isctx, wb16 = !l && !isctx;
        const bf16_t* X1B = (const bf16_t*)(ws + E_X1B) + (size_t)row0 * DM + col;
        const float* src = isctx ? ARGP(AR, I_CTX, z) + (size_t)(row0 - NLAT) * DM + col : ARGP(AR, I_X, z) + (size_t)row0 * DM + col;
        float* dst = isctx ? ctx1_half(ws, row0 - NLAT, pn >> 1) + (col & 511) : EP.out + (size_t)row0 * DM + col;
        const size_t dpitch = isctx ? 512 : DM;
        u32x4 xb[3][2][2];
#define OUT_LOAD(G) do { const size_t rn = (size_t)(128 * ((G) >> 2) + 16 * ((G) & 3)) * DM; \
            _Pragma("unroll") for (int bj = 0; bj < 2; ++bj) { \
                if (rb16) xb[(G) % 3][bj][0] = __builtin_nontemporal_load((const u32x4*)(X1B + rn + 128 * bj)); \
                else { _Pragma("unroll") for (int n = 0; n < 2; ++n) xb[(G) % 3][bj][n] = *(const u32x4*)(src + rn + 128 * bj + 4 * n); } } } while (0)
        OUT_LOAD(0); OUT_LOAD(1);
#pragma unroll
        for (int g = 0; g < 8; ++g) { const int ai = g >> 2, m = g & 3;
            if (g + 2 < 8) OUT_LOAD(g + 2);
#pragma unroll
            for (int bj = 0; bj < 2; ++bj) { f32x4 xa, xc; const u32x4 r0 = xb[g % 3][bj][0], r1 = xb[g % 3][bj][1];
                if (rb16) { xa = (f32x4){__uint_as_float(r0.x << 16), __uint_as_float(r0.x & 0xffff0000u), __uint_as_float(r0.y << 16), __uint_as_float(r0.y & 0xffff0000u)};
                            xc = (f32x4){__uint_as_float(r0.z << 16), __uint_as_float(r0.z & 0xffff0000u), __uint_as_float(r0.w << 16), __uint_as_float(r0.w & 0xffff0000u)}; }
                else { xa = __builtin_bit_cast(f32x4, r0); xc = __builtin_bit_cast(f32x4, r1); }
                xa = xa + gv[bj][0] * acc[ai][bj][m][0]; xc = xc + gv[bj][1] * acc[ai][bj][m][1];
                if (wb16) *(u32x4*)((bf16_t*)(ws + E_X1B) + (size_t)(row0 + 128 * ai + 16 * m) * DM + col + 128 * bj) = pack8(xa, xc);
                else { float* d = dst + (size_t)(128 * ai + 16 * m) * dpitch + 128 * bj; *(f32x4*)d = xa; *(f32x4*)(d + 4) = xc; } }
            asm volatile("" ::: "memory"); }
#undef OUT_LOAD
    }
}

__device__ __forceinline__ void chain_update(f32x4 (&acc)[2][2][4][2], const Unit& u, int wr, int wc, int fr, int fq, const EpiP& EP) {
    asm volatile("" : "+v"(fr), "+v"(fq));
    const bool br1 = u.kind == EK_BR1;
    const int pm = u.pm, pn = u.pn; const bool isctx = pm >= 64; const int row0 = pm * 256 + wr * 64 + fr;
    const unsigned char* gb = g_rows(EP.ws, EP.out, EP.l, isctx, row0);
    bf16_t* MRG = (bf16_t*)(EP.ws + E_HX);
    const int col = 256 * pn + 32 * wc + 8 * fq;
    u32x2 w1b[2][2], w0b[2][2];
#pragma unroll
    for (int bj = 0; bj < 2; ++bj) { w1b[0][bj] = *(const u32x2*)(gb + col + 1024 + 128 * bj); if (br1) w0b[0][bj] = *(const u32x2*)(gb + col + 128 * bj); else w0b[0][bj] = (u32x2){0u, 0u}; }
#pragma unroll
    for (int g = 0; g < 8; ++g) { const int ai = g >> 2, m = g & 3;
        if (g + 1 < 8) { const unsigned char* gn = gb + (size_t)(128 * ((g + 1) >> 2) + 16 * ((g + 1) & 3)) * 2048 + col;
#pragma unroll
            for (int bj = 0; bj < 2; ++bj) { w1b[(g + 1) & 1][bj] = *(const u32x2*)(gn + 1024 + 128 * bj); if (br1) w0b[(g + 1) & 1][bj] = *(const u32x2*)(gn + 128 * bj); else w0b[(g + 1) & 1][bj] = (u32x2){0u, 0u}; } }
#pragma unroll
        for (int bj = 0; bj < 2; ++bj) {
            const u32x2 w1 = w1b[g & 1][bj], w0 = w0b[g & 1][bj];
            const f32x4 g1a = {(float)(w1.x & 255u), (float)((w1.x >> 8) & 255u), (float)((w1.x >> 16) & 255u), (float)(w1.x >> 24)}, g1b = {(float)(w1.y & 255u), (float)((w1.y >> 8) & 255u), (float)((w1.y >> 16) & 255u), (float)(w1.y >> 24)};
            f32x4 ra, rb;
            if (br1) {
                const f32x4 g0a = {(float)(w0.x & 255u), (float)((w0.x >> 8) & 255u), (float)((w0.x >> 16) & 255u), (float)(w0.x >> 24)}, g0b = {(float)(w0.y & 255u), (float)((w0.y >> 8) & 255u), (float)((w0.y >> 16) & 255u), (float)(w0.y >> 24)};
#pragma unroll
                for (int i = 0; i < 4; ++i) { ra[i] = g0a[i] * __builtin_amdgcn_rcpf(g1a[i]); rb[i] = g0b[i] * __builtin_amdgcn_rcpf(g1b[i]); }
            } else {
                *(u32x4*)(MRG + (size_t)(row0 + 128 * ai + 16 * m) * DM + col + 128 * bj) = pack8(acc[ai][bj][m][0] * g1a, acc[ai][bj][m][1] * g1b);
                ra = rb = (f32x4){0.f, 0.f, 0.f, 0.f};
            }
            asm volatile("" : "+v"(ra), "+v"(rb));
            acc[ai][bj][m][0] = acc[ai][bj][m][0] * ra; acc[ai][bj][m][1] = acc[ai][bj][m][1] * rb;
            asm volatile("" : "+v"(acc[ai][bj][m][0]), "+v"(acc[ai][bj][m][1])); }
        asm volatile("" ::: "memory"); }
}

__device__ __forceinline__ void glds16_sb(const void* sbase, unsigned voff, unsigned lds_dst) {
    asm volatile("s_mov_b32 m0, %1\n\ts_nop 0\n\tglobal_load_lds_dwordx4 %0, %2" :: "v"(voff), "s"(lds_dst), "s"(sbase) : "memory", "m0"); }
template <bool CHAIN> __device__ __forceinline__ void gemm_phase(LAS unsigned char* lds, const GSched& S, const EpiP& E, const Args& AR, int tid) {
    const int wid = __builtin_amdgcn_readfirstlane(tid >> 6), lane = tid & 63, wr = wid >> 2, wc = wid & 3, fr = lane & 15, fq = lane >> 4;
    constexpr int K = KD, nt = K / BK;
    unsigned voffA[2];
#pragma unroll
    for (int i = 0; i < 2; ++i) { int R, C; stage_rc(tid * 16 + i * 8192, R, C); voffA[i] = (unsigned)(R * K + C) * 2u; }
    const size_t kstep = (size_t)(BK * 2);
    const size_t hstep = (size_t)HALF * K * 2;
    const unsigned ldsw = (unsigned)wid * 1024u;
    const int aoff = lds_byte(wr * 64 + fr, fq * 8), boff = lds_byte(wc * 32 + fr, fq * 8);
#define PG8_SA(b, h) (((b) * 2 + (h)) * HTB)
#define PG8_SB(b, h) ((4 + (b) * 2 + (h)) * HTB)
    const unsigned ldsb = (unsigned)(uintptr_t)lds;
#define PG8_STAGE(bufoff, gbase) do { _Pragma("unroll") for (int _i = 0; _i < 2; ++_i) glds16_sb((const char*)(gbase), voffA[_i], (unsigned)__builtin_amdgcn_readfirstlane(ldsb + (bufoff) + ldsw + _i * 8192)); } while (0)
#define PG8_LDA(dst, b, h) do { _Pragma("unroll") for (int m = 0; m < 4; ++m) _Pragma("unroll") for (int k = 0; k < 2; ++k) dst[m][k] = *(const LAS bf16x8*)(lds + PG8_SA(b, h) + aoff + m * 2048 + k * 1024); } while (0)
#define PG8_LDB(dst, b, h) do { _Pragma("unroll") for (int n = 0; n < 2; ++n) _Pragma("unroll") for (int k = 0; k < 2; ++k) dst[n][k] = *(const LAS bf16x8*)(lds + PG8_SB(b, h) + boff + n * 2048 + k * 1024); } while (0)
#define PG8_MMA(ai, bj, At, Bt) do { __builtin_amdgcn_s_setprio(1); _Pragma("unroll") for (int m = 0; m < 4; ++m) _Pragma("unroll") for (int n = 0; n < 2; ++n) _Pragma("unroll") for (int k = 0; k < 2; ++k) \
        acc[ai][bj][m][n] = __builtin_amdgcn_mfma_f32_16x16x32_bf16(Bt[n][k], At[m][k], acc[ai][bj][m][n], 0, 0, 0); __builtin_amdgcn_s_setprio(0); } while (0)
#define PG8_WAIT_V(n) asm volatile("s_waitcnt vmcnt(" #n ")" ::: "memory")
#define PG8_WAIT_L(n) asm volatile("s_waitcnt lgkmcnt(" #n ")" ::: "memory")
#define PG8_BAR __builtin_amdgcn_s_barrier()
#define PG8_SCHED __builtin_amdgcn_sched_barrier(0)
    Unit cur, nxt; int ui = 0;
    if (!S.next(0, cur)) return;
    f32x4 acc[2][2][4][2];
#pragma unroll
    for (int a = 0; a < 2; ++a)
#pragma unroll
        for (int b = 0; b < 2; ++b)
#pragma unroll
            for (int m = 0; m < 4; ++m)
#pragma unroll
                for (int n = 0; n < 2; ++n) acc[a][b][m][n] = (f32x4){0.f, 0.f, 0.f, 0.f};
    bf16x8 At[4][2], B0[2][2], B1[2][2];
    const char* cA = cur.A; const char* cB = cur.B;
    PG8_STAGE(PG8_SB(0, 0), cB); PG8_STAGE(PG8_SB(0, 1), cB + hstep); PG8_STAGE(PG8_SA(0, 0), cA); PG8_STAGE(PG8_SA(0, 1), cA + hstep);
    if (wr == 1) PG8_BAR;
    PG8_WAIT_V(2); PG8_BAR;
    PG8_STAGE(PG8_SB(1, 0), cB + kstep); PG8_STAGE(PG8_SA(1, 0), cA + kstep); PG8_STAGE(PG8_SB(1, 1), cB + hstep + kstep);
    PG8_WAIT_V(6); PG8_BAR;
    for (;;) {
        const bool has_next = S.next(ui + 1, nxt);
        const char* nA = has_next ? nxt.A : cA; const char* nB = has_next ? nxt.B : cB;
        for (int t = 0; t < nt; t += 2) {
            const bool last = (t == nt - 2);
            const char* a1 = cA + (size_t)(t + 1) * kstep;
            const char* a2 = last ? nA : cA + (size_t)(t + 2) * kstep; const char* b2 = last ? nB : cB + (size_t)(t + 2) * kstep;
            const char* a3 = a2 + kstep; const char* b3 = b2 + kstep;
            PG8_LDB(B0, 0, 0); PG8_LDB(B1, 0, 1); PG8_SCHED; PG8_LDA(At, 0, 0); PG8_STAGE(PG8_SA(1, 1), a1 + hstep);
            PG8_WAIT_V(8); PG8_WAIT_L(0); PG8_BAR; PG8_MMA(0, 0, At, B0); PG8_MMA(0, 1, At, B1); PG8_BAR; PG8_SCHED;
            PG8_LDA(At, 0, 1); PG8_STAGE(PG8_SB(0, 0), b2); PG8_STAGE(PG8_SB(0, 1), b2 + hstep); PG8_STAGE(PG8_SA(0, 0), a2);
            PG8_WAIT_V(8); PG8_WAIT_L(0); PG8_BAR; PG8_MMA(1, 0, At, B0); PG8_MMA(1, 1, At, B1); PG8_BAR; PG8_SCHED;
            PG8_LDB(B0, 1, 0); PG8_LDB(B1, 1, 1); PG8_SCHED; PG8_LDA(At, 1, 0); PG8_STAGE(PG8_SA(0, 1), a2 + hstep);
            PG8_WAIT_V(8); PG8_WAIT_L(0); PG8_BAR; PG8_MMA(0, 0, At, B0); PG8_MMA(0, 1, At, B1); PG8_BAR; PG8_SCHED;
            PG8_LDA(At, 1, 1); PG8_STAGE(PG8_SB(1, 0), b3); PG8_STAGE(PG8_SB(1, 1), b3 + hstep); PG8_STAGE(PG8_SA(1, 0), a3);
            PG8_WAIT_V(8); PG8_WAIT_L(0); PG8_BAR; PG8_MMA(1, 0, At, B0); PG8_MMA(1, 1, At, B1); PG8_BAR; PG8_SCHED;
        }
        if (wr == 0) PG8_BAR;
        if constexpr (CHAIN) chain_update(acc, cur, wr, wc, fr, fq, E);
        else {
            epilogue(acc, cur, wr, wc, fr, fq, E, AR);
#pragma unroll
            for (int a = 0; a < 2; ++a)
#pragma unroll
                for (int b = 0; b < 2; ++b)
#pragma unroll
                    for (int m = 0; m < 4; ++m)
#pragma unroll
                        for (int n = 0; n < 2; ++n) acc[a][b][m][n] = (f32x4){0.f, 0.f, 0.f, 0.f};
        }
        if (!has_next) break;
        cur = nxt; cA = nA; cB = nB; ++ui;
        if (wr == 1) PG8_BAR;
    }
    PG8_WAIT_V(0);
    PG8_BAR;
#undef PG8_SA
#undef PG8_SB
#undef PG8_STAGE
#undef PG8_LDA
#undef PG8_LDB
#undef PG8_MMA
#undef PG8_WAIT_V
#undef PG8_WAIT_L
#undef PG8_BAR
#undef PG8_SCHED
}
}
namespace attn_body {
using bf16=__hip_bfloat16;
using bf16x8=__attribute__((ext_vector_type(8)))short;
using s16x4=__attribute__((ext_vector_type(4)))short;
using f32x16=__attribute__((ext_vector_type(16)))float;
using u32x4=__attribute__((ext_vector_type(4)))unsigned;
constexpr int D=64,QP=1024,KP=256;
constexpr int NW=8,QBLK=32,QB=QBLK*NW,KVBLK=64;
__device__ __forceinline__ int crow(int r,int hi){return (r&3)+8*(r>>2)+4*hi;}
#define SBAR() __builtin_amdgcn_sched_barrier(0)
constexpr int NSLOT=3, SLOTB=8192;
constexpr int LDS_K=0, LDS_V=NSLOT*SLOTB, LDS_WS=2*NSLOT*SLOTB, LDS_OST=LDS_WS+NW*64*4, LDS_ZST=LDS_OST+NW*4096, LDS_BYTES=LDS_ZST+NW*4096;
__device__ __forceinline__ void glds16(const void*gsrc,unsigned lds_dst){unsigned keep;
  asm volatile("s_mov_b32 %0, m0\n\ts_mov_b32 m0, %2\n\ts_nop 0\n\tglobal_load_lds_dwordx4 %1, off\n\ts_mov_b32 m0, %0":"=&s"(keep):"v"(gsrc),"s"(lds_dst):"memory");}
__device__ __forceinline__ void glds16s(const void*sbase,unsigned voff,unsigned lds_dst){
  asm volatile("s_mov_b32 m0, %1\n\ts_nop 0\n\tglobal_load_lds_dwordx4 %0, %2"::"v"(voff),"s"(lds_dst),"s"(sbase):"memory","m0");}
__device__ __forceinline__ float max3f(float a,float b,float c){float r;asm("v_max3_f32 %0, %1, %2, %3":"=v"(r):"v"(a),"v"(b),"v"(c));return r;}
__device__ __forceinline__ float max2f(float a,float b){float r;asm("v_max_f32_e32 %0, %1, %2":"=v"(r):"v"(a),"v"(b));return r;}
__device__ __forceinline__ float fadd_s(float a,float b){float r;asm("v_add_f32_e32 %0, %1, %2":"=v"(r):"v"(a),"v"(b));return r;}
__device__ __forceinline__ float fsub_s(float a,float b){float r;asm("v_sub_f32_e32 %0, %1, %2":"=v"(r):"v"(a),"v"(b));return r;}
typedef float f32x2_t __attribute__((ext_vector_type(2))); typedef __bf16 bf16x2_t __attribute__((ext_vector_type(2)));
__device__ __forceinline__ unsigned cvtpk_s(float lo,float hi){f32x2_t v={lo,hi};bf16x2_t b=__builtin_convertvector(v,bf16x2_t);return __builtin_bit_cast(unsigned,b);}
#define WAIT_BAR(N) asm volatile("s_waitcnt vmcnt(" #N ") lgkmcnt(0)\n\ts_barrier":::"memory")

__device__ __forceinline__ void qkt(f32x16&p0,f32x16&p1,const char*Kslot,const bf16x8*qr,const f32x16&negm,int r32,int hi){
  const char*kb=Kslot+hi*1024+r32*16;
  #pragma unroll
  for(int d0=0;d0<4;++d0){
    const bf16x8 b0=*reinterpret_cast<const bf16x8*>(kb+d0*2048);
    const bf16x8 b1=*reinterpret_cast<const bf16x8*>(kb+d0*2048+512);
    if(d0==0){p0=__builtin_amdgcn_mfma_f32_32x32x16_bf16(b0,qr[0],negm,0,0,0);p1=__builtin_amdgcn_mfma_f32_32x32x16_bf16(b1,qr[0],negm,0,0,0);}
    else{p0=__builtin_amdgcn_mfma_f32_32x32x16_bf16(b0,qr[d0],p0,0,0,0);p1=__builtin_amdgcn_mfma_f32_32x32x16_bf16(b1,qr[d0],p1,0,0,0);}}
}
typedef __attribute__((address_space(3))) const char* lds_cptr;
typedef short v4i16_t __attribute__((ext_vector_type(4)));
__device__ __forceinline__ void kload8(bf16x8*kf,lds_cptr kp){
  kf[0]=*(const __attribute__((address_space(3))) bf16x8*)(kp);      kf[1]=*(const __attribute__((address_space(3))) bf16x8*)(kp+512);
  kf[2]=*(const __attribute__((address_space(3))) bf16x8*)(kp+2048); kf[3]=*(const __attribute__((address_space(3))) bf16x8*)(kp+2560);
  kf[4]=*(const __attribute__((address_space(3))) bf16x8*)(kp+4096); kf[5]=*(const __attribute__((address_space(3))) bf16x8*)(kp+4608);
  kf[6]=*(const __attribute__((address_space(3))) bf16x8*)(kp+6144); kf[7]=*(const __attribute__((address_space(3))) bf16x8*)(kp+6656);
}
__device__ __forceinline__ void kload2(bf16x8*kf,lds_cptr kp,int j){ kf[2*j]=*(const __attribute__((address_space(3))) bf16x8*)(kp+j*2048); kf[2*j+1]=*(const __attribute__((address_space(3))) bf16x8*)(kp+j*2048+512); }
__device__ __forceinline__ s16x4 vtr(lds_cptr p){ return __builtin_bit_cast(s16x4,__builtin_amdgcn_ds_read_tr16_b64_v4i16((__attribute__((address_space(3))) v4i16_t*)p)); }
__device__ __forceinline__ float rowmax(const f32x16&p0,const f32x16&p1){
  float a=max3f(p0[0],p0[1],p1[0]),b=max3f(p0[2],p0[3],p1[1]);a=max3f(a,p1[2],p1[3]);
  #pragma unroll
  for(int r=4;r<16;r+=4){a=max3f(a,p0[r],p0[r+1]);b=max3f(b,p0[r+2],p0[r+3]);a=max3f(a,p1[r],p1[r+1]);b=max3f(b,p1[r+2],p1[r+3]);}
  const float m=max2f(a,b);
  auto rr=__builtin_amdgcn_permlane32_swap(__float_as_uint(m),__float_as_uint(m),false,false);
  return max2f(__uint_as_float(rr[0]),__uint_as_float(rr[1]));
}
__device__ __forceinline__ void pv(f32x16*o,int vb,bf16x8 pa0,bf16x8 pa1,bf16x8 pa2,bf16x8 pa3){
  #pragma unroll
  for(int d0=0;d0<2;++d0){s16x4 lo[4],hi[4];
    #pragma unroll
    for(int ks=0;ks<4;++ks){
      asm volatile("ds_read_b64_tr_b16 %0,%1 offset:%c2":"=&v"(lo[ks]):"v"(vb),"i"(d0*4096+ks*1024):"memory");
      asm volatile("ds_read_b64_tr_b16 %0,%1 offset:%c2":"=&v"(hi[ks]):"v"(vb),"i"(d0*4096+ks*1024+512):"memory");}
    asm volatile("s_waitcnt lgkmcnt(0)":::"memory");SBAR();
    #define PK(k) (bf16x8){lo[k][0],lo[k][1],lo[k][2],lo[k][3],hi[k][0],hi[k][1],hi[k][2],hi[k][3]}
    o[d0]=__builtin_amdgcn_mfma_f32_32x32x16_bf16(pa0,PK(0),o[d0],0,0,0);
    o[d0]=__builtin_amdgcn_mfma_f32_32x32x16_bf16(pa1,PK(1),o[d0],0,0,0);
    o[d0]=__builtin_amdgcn_mfma_f32_32x32x16_bf16(pa2,PK(2),o[d0],0,0,0);
    o[d0]=__builtin_amdgcn_mfma_f32_32x32x16_bf16(pa3,PK(3),o[d0],0,0,0);
    #undef PK
  }
}

#ifndef ATTN_STORE16
#define ATTN_STORE16(p,v) (*(u32x4*)(p)=(v))
#endif
template<int THRL,bool NOMAX> __device__ __forceinline__ void attn_unit(long qrow0,int h,long krow0,int kvh,int NT,const bf16*Q,const bf16*__restrict__ K,const bf16*__restrict__ V,const bf16*__restrict__ SZ,bf16*O,char*shm,bool pre,long nk,long nq,bf16x8(&qc)[4]){
  int tid=threadIdx.x; asm volatile("":"+v"(tid)); const int lane=tid&63,r32=lane&31,hi=lane>>5; const int wid=__builtin_amdgcn_readfirstlane(tid>>6);
  const bf16*Qw=Q+(qrow0+wid*QBLK)*QP+h*D;
  const bf16*Kh=K+krow0*4096,*Vh=V+krow0*4096;
  const unsigned lds0=(unsigned)(uintptr_t)shm;
  float*wsf=(float*)(shm+LDS_WS)+wid*64;
  const unsigned kvoff=(unsigned)(wid*512+lane*8)*2u;
  const unsigned kdst=lds0+LDS_K+wid*1024, vdst=lds0+LDS_V+wid*1024;
  #define DMA_K(t,slot) glds16s(Kh+(long)(t)*4096,kvoff,(unsigned)__builtin_amdgcn_readfirstlane(kdst+(slot)))
  #define DMA_V(t,slot) glds16s(Vh+(long)(t)*4096,kvoff,(unsigned)__builtin_amdgcn_readfirstlane(vdst+(slot)))
  const int vb0=(int)(lds0+LDS_V)+((lane>>4)&1)*32+(lane&3)*8+(4*hi+((lane&15)>>2))*64;
  const char*Kbase=shm+LDS_K; bf16x8 kf[8];
  const lds_cptr shm3=(lds_cptr)shm; const lds_cptr kp0=shm3+LDS_K+hi*1024+r32*16; const lds_cptr vp0=shm3+LDS_V+((lane>>4)&1)*32+(lane&3)*8+(4*hi+((lane&15)>>2))*64;
  if(!pre){DMA_K(0,0);DMA_V(0,0);DMA_K(1,SLOTB);}
  bf16x8 qr[4];
  if(!pre){
    #pragma unroll
    for(int d0=0;d0<4;++d0)qr[d0]=*reinterpret_cast<const bf16x8*>(&Qw[(long)r32*QP+d0*16+hi*8]); }
  else{
    #pragma unroll
    for(int d0=0;d0<4;++d0)qr[d0]=qc[d0]; }
  float mhat=0.f,l_reg=0.f;
  typedef __attribute__((ext_vector_type(4))) float f32x4_t; f32x4_t lsum={0.f,0.f,0.f,0.f};
  const short one_=((((lane&15)<8)?0:1)==((lane>>4)&1))?(short)0x3F80:(short)0; bf16x8 onesA={one_,one_,one_,one_,one_,one_,one_,one_}; if constexpr(NOMAX)asm volatile("":"+v"(onesA));
  f32x16 o[2];o[0]=f32x16{};o[1]=f32x16{};f32x16 negm=f32x16{};if constexpr(!NOMAX)asm volatile("":"+v"(negm));
  #define CMASK(P0,P1,t) do{}while(0)
  bool resc=false;
  #define START(P0,P1) do{ resc=false; \
    if constexpr(!NOMAX){ const float rm=rowmax(P0,P1); const float dl=rm; mhat=fadd_s(mhat,dl); \
      _Pragma("unroll") for(int r=0;r<16;++r){P0[r]=fsub_s(P0[r],dl);P1[r]=fsub_s(P1[r],dl);} \
      _Pragma("unroll") for(int r=0;r<16;++r)negm[r]=-mhat; asm volatile("":"+v"(negm)); } \
    _Pragma("unroll") for(int r=0;r<16;++r)P0[r]=__builtin_amdgcn_exp2f(P0[r]); }while(0)
  #define RESC() do{ if constexpr(!NOMAX) if(resc){ asm volatile("s_waitcnt lgkmcnt(0)":::"memory"); \
      _Pragma("unroll") for(int d_=0;d_<2;++d_) _Pragma("unroll") for(int r=0;r<16;++r)o[d_][r]*=wsf[crow(r,hi)]; } }while(0)
  f32x16 pA0,pA1,pB0,pB1;
  int sl_prev=0,sl_cur=0,sl_next=SLOTB;
  #define ROT() do{sl_prev=sl_cur;sl_cur=sl_next;sl_next=(sl_next==(NSLOT-1)*SLOTB)?0:sl_next+SLOTB;}while(0)
  if(!pre){DMA_K(2,2*SLOTB);}
  if(pre){WAIT_BAR(4);}
  else{WAIT_BAR(3);}
  qkt(pA0,pA1,Kbase,qr,negm,r32,hi);asm volatile("s_nop 15\n\ts_nop 7":"+v"(pA0),"+v"(pA1));CMASK(pA0,pA1,0);
  START(pA0,pA1);
  _Pragma("unroll") for(int r=0;r<16;++r)pA1[r]=__builtin_amdgcn_exp2f(pA1[r]);
  WAIT_BAR(0);
  DMA_K(3,0);DMA_V(1,SLOTB);
  ROT();
  kload8(kf,kp0+sl_cur);
  WAIT_BAR(2);
  { const bf16*Zw=SZ+(qrow0+wid*QBLK)*QP+h*D;
    #pragma unroll
    for(int i=0;i<4;++i)glds16(Zw+(long)(i*8+(lane>>3))*QP+(lane&7)*8,(unsigned)__builtin_amdgcn_readfirstlane(lds0+LDS_ZST+wid*4096+i*1024)); }
  s16x4 vlo[8],vhi[8]; u32x4 pw0,pw1,pw2,pw3;
  #define PKW(P,B) cvtpk_s(P[B],P[B+1])
  #define PAF(k) __builtin_bit_cast(bf16x8,pw##k)
  #define VFR(i) (bf16x8){vlo[i][0],vlo[i][1],vlo[i][2],vlo[i][3],vhi[i][0],vhi[i][1],vhi[i][2],vhi[i][3]}
  #define PIN(x) asm volatile("":"+v"(x))
  #define MX3(a,b,c) __builtin_fmaxf(__builtin_fmaxf((a),(b)),(c))
  #define GAPA(MF,A0,A1,A2,A3,W0,W1,PW) do{ MF; if constexpr(!NOMAX){ sacc+=A0; sacc+=A1; sacc+=A2; sacc+=A3; PIN(sacc); } W0; W1; PIN(PW); SBAR(); }while(0)
  #define GAPA2(MF,A0,A1,W0,W1,PW) do{ MF; if constexpr(!NOMAX){ sacc+=A0; sacc+=A1; PIN(sacc); } W0; W1; PIN(PW); SBAR(); }while(0)
  #define LSUM(k) do{ if constexpr(NOMAX){ lsum=__builtin_amdgcn_mfma_f32_16x16x32_bf16(onesA,PAF(k),lsum,0,0,0); SBAR(); } }while(0)
  #define EX(v) __builtin_amdgcn_exp2f(v)
  #define GAPB(MF,X,B) do{ MF; X[B]=EX(X[B]); X[B+1]=EX(X[B+1]); X[B+2]=EX(X[B+2]); X[B+3]=EX(X[B+3]); PIN(X); SBAR(); }while(0)
  #define VRD(i) do{ vlo[i]=vtr(vp_+(((i)>>2)*4096+((i)&3)*1024)); vhi[i]=vtr(vp_+(((i)>>2)*4096+((i)&3)*1024+512)); }while(0)
  #define KRD(G,j) do{ if(G){ kload2(kf,kp0+sl_next,j); SBAR(); } }while(0)
  #define STEP(C0,C1,P0,P1,t,GK,GV,GL) do{ SBAR(); \
    const lds_cptr vp_=vp0+sl_prev; \
    VRD(0); SBAR(); float sacc=NOMAX?0.f:(P0[0]+P0[1]); \
    GAPA(C0=__builtin_amdgcn_mfma_f32_32x32x16_bf16(kf[0],qr[0],negm,0,0,0), P0[2],P0[3],P0[4],P0[5],     pw0[0]=PKW(P0,0), pw0[1]=PKW(P0,2), pw0); \
    VRD(4); SBAR(); GAPA(C1=__builtin_amdgcn_mfma_f32_32x32x16_bf16(kf[1],qr[0],negm,0,0,0), P0[6],P0[7],P0[8],P0[9],     pw0[2]=PKW(P0,4), pw0[3]=PKW(P0,6), pw0); \
    VRD(1); SBAR(); GAPA(C0=__builtin_amdgcn_mfma_f32_32x32x16_bf16(kf[2],qr[1],C0,0,0,0),   P0[10],P0[11],P0[12],P0[13], pw1[0]=PKW(P0,8), pw1[1]=PKW(P0,10), pw1); \
    VRD(5); SBAR(); GAPA(C1=__builtin_amdgcn_mfma_f32_32x32x16_bf16(kf[3],qr[1],C1,0,0,0),   P0[14],P0[15],P1[0],P1[1],   pw1[2]=PKW(P0,12),pw1[3]=PKW(P0,14), pw1); \
    VRD(2); SBAR(); GAPA(C0=__builtin_amdgcn_mfma_f32_32x32x16_bf16(kf[4],qr[2],C0,0,0,0),   P1[2],P1[3],P1[4],P1[5],     pw2[0]=PKW(P1,0), pw2[1]=PKW(P1,2), pw2); \
    VRD(6); SBAR(); GAPA(C1=__builtin_amdgcn_mfma_f32_32x32x16_bf16(kf[5],qr[2],C1,0,0,0),   P1[6],P1[7],P1[8],P1[9],     pw2[2]=PKW(P1,4), pw2[3]=PKW(P1,6), pw2); \
    VRD(3); SBAR(); GAPA(C0=__builtin_amdgcn_mfma_f32_32x32x16_bf16(kf[6],qr[3],C0,0,0,0),   P1[10],P1[11],P1[12],P1[13], pw3[0]=PKW(P1,8), pw3[1]=PKW(P1,10), pw3); \
    VRD(7); SBAR(); GAPA2(C1=__builtin_amdgcn_mfma_f32_32x32x16_bf16(kf[7],qr[3],C1,0,0,0),  P1[14],P1[15],               pw3[2]=PKW(P1,12),pw3[3]=PKW(P1,14), pw3); \
    if constexpr(!NOMAX) l_reg+=sacc; \
    if(GK){DMA_K((t)+3,sl_cur);} if(GV){DMA_V((t)+1,sl_next);} \
    CMASK(C0,C1,t); \
    if constexpr(!NOMAX){ float a=MX3(C0[0],C0[1],C1[0]),b=MX3(C0[2],C0[3],C1[1]); a=MX3(a,C1[2],C1[3]); \
      _Pragma("unroll") for(int r=4;r<16;r+=4){a=MX3(a,C0[r],C0[r+1]);b=MX3(b,C0[r+2],C0[r+3]);a=MX3(a,C1[r],C1[r+1]);b=MX3(b,C1[r+2],C1[r+3]);} \
      float rm=__builtin_fmaxf(a,b); { auto rr=__builtin_amdgcn_permlane32_swap(__float_as_uint(rm),__float_as_uint(rm),false,false); rm=__builtin_fmaxf(__uint_as_float(rr[0]),__uint_as_float(rr[1])); } \
      resc=false; \
      if(__builtin_expect(__any(rm>(float)THRL),0)){ const float dl=__builtin_fmaxf(rm,0.f); mhat+=dl; \
        _Pragma("unroll") for(int r=0;r<16;++r){C0[r]-=dl;C1[r]-=dl;} \
        _Pragma("unroll") for(int r=0;r<16;++r)negm[r]=-mhat; asm volatile("":"+v"(negm)); \
        const float f=__builtin_amdgcn_exp2f(-dl); l_reg*=f; if(hi==0)wsf[r32]=f; resc=true; } } \
    SBAR(); \
    GAPB(o[0]=__builtin_amdgcn_mfma_f32_32x32x16_bf16(PAF(0),VFR(0),o[0],0,0,0), C0,0); \
    GAPB(o[1]=__builtin_amdgcn_mfma_f32_32x32x16_bf16(PAF(0),VFR(4),o[1],0,0,0), C0,4); LSUM(0); \
    KRD(GL,0); GAPB(o[0]=__builtin_amdgcn_mfma_f32_32x32x16_bf16(PAF(1),VFR(1),o[0],0,0,0), C0,8); \
    KRD(GL,1); GAPB(o[1]=__builtin_amdgcn_mfma_f32_32x32x16_bf16(PAF(1),VFR(5),o[1],0,0,0), C0,12); LSUM(1); \
    KRD(GL,2); GAPB(o[0]=__builtin_amdgcn_mfma_f32_32x32x16_bf16(PAF(2),VFR(2),o[0],0,0,0), C1,0); \
    KRD(GL,3); GAPB(o[1]=__builtin_amdgcn_mfma_f32_32x32x16_bf16(PAF(2),VFR(6),o[1],0,0,0), C1,4); LSUM(2); \
    GAPB(o[0]=__builtin_amdgcn_mfma_f32_32x32x16_bf16(PAF(3),VFR(3),o[0],0,0,0), C1,8); \
    GAPB(o[1]=__builtin_amdgcn_mfma_f32_32x32x16_bf16(PAF(3),VFR(7),o[1],0,0,0), C1,12); LSUM(3); \
    }while(0)
  int t=1;
  #undef CMASK
  #define CMASK(P0,P1,t) do{}while(0)
  for(;t+5<NT;t+=2){
    STEP(pB0,pB1,pA0,pA1,t,true,true,true);     if(t==1){WAIT_BAR(6);}else{WAIT_BAR(2);} RESC(); ROT();
    STEP(pA0,pA1,pB0,pB1,t+1,true,true,true);   WAIT_BAR(2); RESC(); ROT();
  }
  #undef CMASK
  #define CMASK(P0,P1,t) do{}while(0)
  #define ENDW(tt) do{ if((tt)+3<NT){WAIT_BAR(2);} else if((tt)+2<NT){WAIT_BAR(1);} else {WAIT_BAR(0);} }while(0)
  for(;t+1<NT;t+=2){
    STEP(pB0,pB1,pA0,pA1,t,(t+3<NT),(t+1<NT),(t+1<NT));       ENDW(t);   RESC(); ROT();
    STEP(pA0,pA1,pB0,pB1,t+1,(t+4<NT),(t+2<NT),(t+2<NT));     ENDW(t+1); RESC(); ROT();
  }
  if(nk>=0){ const bf16*kn=K+nk*4096,*vn=V+nk*4096;
    glds16s(kn,kvoff,(unsigned)__builtin_amdgcn_readfirstlane(kdst)); glds16s(vn,kvoff,(unsigned)__builtin_amdgcn_readfirstlane(vdst)); glds16s(kn+4096,kvoff,(unsigned)__builtin_amdgcn_readfirstlane(kdst+SLOTB)); glds16s(kn+2*4096,kvoff,(unsigned)__builtin_amdgcn_readfirstlane(kdst+2*SLOTB));
    const bf16*Qn=Q+nq+(long)wid*QBLK*QP;
    #pragma unroll
    for(int d0=0;d0<4;++d0)qc[d0]=*reinterpret_cast<const bf16x8*>(&Qn[(long)r32*QP+d0*16+hi*8]); }
  STEP(pB0,pB1,pA0,pA1,NT-1,false,false,false); RESC();
  { if constexpr(!NOMAX){ float sacc=pB0[0]+pB0[1]; _Pragma("unroll") for(int r=2;r<16;++r)sacc+=pB0[r]; _Pragma("unroll") for(int r=0;r<16;++r)sacc+=pB1[r]; l_reg+=sacc; }
    pw0=(u32x4){PKW(pB0,0),PKW(pB0,2),PKW(pB0,4),PKW(pB0,6)};pw1=(u32x4){PKW(pB0,8),PKW(pB0,10),PKW(pB0,12),PKW(pB0,14)};pw2=(u32x4){PKW(pB1,0),PKW(pB1,2),PKW(pB1,4),PKW(pB1,6)};pw3=(u32x4){PKW(pB1,8),PKW(pB1,10),PKW(pB1,12),PKW(pB1,14)};
    SBAR(); pv(o,vb0+sl_cur,PAF(0),PAF(1),PAF(2),PAF(3)); LSUM(0); LSUM(1); LSUM(2); LSUM(3); }
  #undef PKW
  #undef PAF
  #undef VFR
  #undef PIN
  #undef MX3
  #undef GAPA
  #undef GAPA2
  #undef LSUM
  #undef GAPB
  #undef EX
  #undef VRD
  #undef KRD
  #undef STEP
  #undef ENDW
  if constexpr(NOMAX){ asm volatile("s_nop 7":"+v"(lsum)); if((lane&16)==0)wsf[32+(lane&15)+((lane>>5)<<4)]=lsum[0]; }
  else{ {auto rr=__builtin_amdgcn_permlane32_swap(__float_as_uint(l_reg),__float_as_uint(l_reg),false,false);l_reg=__uint_as_float(rr[0])+__uint_as_float(rr[1]);}
    if(hi==0)wsf[32+r32]=l_reg; }
  asm volatile("s_waitcnt lgkmcnt(0)":::"memory");
  float rli[16];
  #pragma unroll
  for(int r=0;r<16;++r)rli[r]=__builtin_amdgcn_rcpf(wsf[32+crow(r,hi)]);
  bf16*Ow=O+(qrow0+wid*QBLK)*QP+h*D;
  { bf16*stg=(bf16*)(shm+LDS_OST)+wid*2048; const bf16*zst=(const bf16*)(shm+LDS_ZST)+wid*2048;
    #pragma unroll
    for(int r=0;r<16;++r){const int orow=crow(r,hi);
      #pragma unroll
      for(int d0=0;d0<2;++d0)stg[orow*64+d0*32+r32]=__float2bfloat16(o[d0][r]*rli[r]);}
    asm volatile("s_waitcnt lgkmcnt(0)":::"memory");
    #pragma unroll
    for(int i=0;i<4;++i){const int row=i*8+(lane>>3),ch=lane&7; const u32x4 v=*(const u32x4*)(stg+row*64+ch*8); const u32x4 z=*(const u32x4*)(zst+row*64+ch*8); u32x4 w;
      #pragma unroll
      for(int e=0;e<4;++e){ const float lo=__uint_as_float(v[e]<<16)*__uint_as_float(z[e]<<16), hh=__uint_as_float(v[e]&0xffff0000u)*__uint_as_float(z[e]&0xffff0000u); w[e]=cvtpk_s(lo,hh); }
      ATTN_STORE16(Ow+(long)row*QP+ch*8,w);} }
  asm volatile("s_waitcnt lgkmcnt(0)\n\ts_barrier":::"memory");
  #undef DMA_K
  #undef DMA_V
  #undef CMASK
  #undef START
  #undef RESC
  #undef ROT
}
constexpr int ATTN_LDS_BYTES=LDS_BYTES;
#undef SBAR
#undef WAIT_BAR
}
constexpr size_t MiB = 1u << 20;
constexpr size_t WS_CTL = 0, CTL_ZERO_BYTES = 64 * 1024;
constexpr size_t WS_MOD = 1 * MiB;
constexpr size_t WS_ROPEC = WS_MOD + 256 * 1024, WS_ROPES = WS_ROPEC + 4096;
constexpr size_t WS_W = 2 * MiB, W_LAYER = 23 * MiB, W_IN = 0, W_A = 17 * MiB, W_C = 19 * MiB, W_O = 21 * MiB;
using pg8::e_k; using pg8::e_v; using pg8::e_sza; using pg8::e_u; using pg8::e_yz;
constexpr size_t WS_HX = pg8::E_HX, WS_Q = pg8::E_Q;
constexpr size_t WS_END = 264 * MiB;
__device__ __forceinline__ unsigned char* w_ptr(unsigned char* ws, int l, int which) { return which == 0 ? ws + WS_W + (size_t)l * W_LAYER : l ? ws + WS_W + W_LAYER + (17 + 2 * (which - 1)) * MiB : ws + (258 + 2 * (which - 1)) * MiB; }

constexpr int RING_OFF = 0, RING_BYTES = 131072;
constexpr int LDSCTL_OFF = RING_BYTES, MISC_OFF = LDSCTL_OFF + 320, EPI_TAB_OFF = LDSCTL_OFF + 1024;
constexpr int LDS_BYTES = 147456;
constexpr int NWAVES = 8;
constexpr int N_PHASES = 11;
constexpr int N_LAUNCHES = MK_N_LAUNCHES;
static_assert(N_LAUNCHES == 1 || N_LAUNCHES == N_PHASES, "MK_N_LAUNCHES is 1 or 11");

typedef GAS unsigned gu32;
#define RLX_AGENT __ATOMIC_RELAXED, __HIP_MEMORY_SCOPE_AGENT
#define LDS_WAIT() asm volatile("s_waitcnt lgkmcnt(0)" ::: "memory")
#define VM_WAIT() asm volatile("s_waitcnt vmcnt(0)" ::: "memory")

#define XB_TMO      128
#define XB_XCNT(j)  (256  + 64 * (j))
#define XB_XSUB(j)  (1280 + 64 * (j))
#define XB_XGEN(j)  (2304 + 64 * (j))
#define XB_TOP      3328
#define XB_TOPGEN   3392
#define XCD_BAR_WORDS 3456
#define XB_SPIN_CAP (1u << 18)

__device__ __forceinline__ unsigned xb_ld(unsigned* p)              { return __hip_atomic_load(p, __ATOMIC_RELAXED, __HIP_MEMORY_SCOPE_AGENT); }
__device__ __forceinline__ unsigned xb_add(unsigned* p, unsigned v) { return __hip_atomic_fetch_add(p, v, __ATOMIC_RELAXED, __HIP_MEMORY_SCOPE_AGENT); }
__device__ __forceinline__ unsigned xb_xcc_id() { return (unsigned)__builtin_amdgcn_s_getreg((3 << 11) | 20) & 0xFu; }
#define XB_SPIN(cond, bar) do { unsigned _sp = 0; while (cond) { __builtin_amdgcn_s_sleep(1); \
    if ((++_sp & 255u) == 0u) { if (xb_ld(&(bar)[XB_TMO])) break; if (_sp > XB_SPIN_CAP) { atomicAdd(&(bar)[XB_TMO], 1u); break; } } } } while (0)

struct XcdBarrier {
    unsigned* bar; unsigned x;
    volatile LAS unsigned* st;
};

__device__ __forceinline__ XcdBarrier xcd_barrier_post(unsigned* bar, volatile LAS unsigned* st) {
    XcdBarrier b; b.bar = bar; b.x = xb_xcc_id(); b.st = st;
    if (threadIdx.x == 0) (void)xb_add(&bar[XB_XCNT(b.x)], 1u);
    return b;
}
__device__ __forceinline__ void xcd_barrier_complete(unsigned* bar, unsigned x, unsigned& nloc, unsigned& nx) {
    const unsigned G = gridDim.x * gridDim.y * gridDim.z;
    unsigned sum, cnt, mine, sp = 0u;
    for (;;) {
        sum = 0u; cnt = 0u; mine = 0u;
#pragma unroll
        for (unsigned j = 0; j < 16; ++j) { const unsigned c = xb_ld(&bar[XB_XCNT(j)]); sum += c; cnt += (c > 0u) ? 1u : 0u; mine = (j == x) ? c : mine; }
        if (sum == G) break;
        __builtin_amdgcn_s_sleep(1);
        if ((++sp & 255u) == 0u) { if (xb_ld(&bar[XB_TMO])) break; if (sp > XB_SPIN_CAP) { atomicAdd(&bar[XB_TMO], 1u); break; } }
    }
    nloc = mine > 0u ? mine : 1u; nx = cnt > 0u ? cnt : 1u;
}

__device__ __forceinline__ void xcd_barrier(const XcdBarrier& b) {
    asm volatile("s_waitcnt vmcnt(0)" ::: "memory");
    __syncthreads();
    if (threadIdx.x == 0) {
        unsigned* bar = b.bar;
        __builtin_amdgcn_s_waitcnt(0);
        unsigned nloc = b.st[0], nx = b.st[1];
        if (nloc == 0u) { xcd_barrier_complete(bar, b.x, nloc, nx); b.st[0] = nloc; b.st[1] = nx; }
        const unsigned old = xb_add(&bar[XB_XSUB(b.x)], 1u);
        const unsigned gen = old / nloc;
        if (old + 1u == (gen + 1u) * nloc) {
            __builtin_amdgcn_fence(__ATOMIC_RELEASE, "agent");
            asm volatile("s_waitcnt vmcnt(0)" ::: "memory");
            const unsigned og = xb_add(&bar[XB_TOP], 1u);
            const unsigned tg = og / nx;
            if (og + 1u == (tg + 1u) * nx) xb_add(&bar[XB_TOPGEN], 1u);
            else XB_SPIN(xb_ld(&bar[XB_TOPGEN]) == tg, bar);
            __builtin_amdgcn_fence(__ATOMIC_ACQUIRE, "agent");
            xb_add(&bar[XB_XGEN(b.x)], 1u);
            asm volatile("s_waitcnt vmcnt(0)" ::: "memory");
        } else {
            XB_SPIN(xb_ld(&bar[XB_XGEN(b.x)]) == gen, bar);
            __builtin_amdgcn_fence(__ATOMIC_ACQUIRE, "agent");
            asm volatile("s_waitcnt vmcnt(0)" ::: "memory");
        }
    }
    __syncthreads();
}


constexpr int CW_BAR = 1024;
static_assert((CW_BAR + XCD_BAR_WORDS) * 4 <= (int)CTL_ZERO_BYTES, "control words inside the memset region");
static_assert(attn_body::ATTN_LDS_BYTES <= RING_BYTES, "attention scratch inside the ring region");


__device__ __forceinline__ float wave_max(float v) {
#pragma unroll
    for (int o = 1; o < 64; o <<= 1) v = fmaxf(v, __shfl_xor(v, o));
    return v;
}
__device__ __forceinline__ float wave_sum(float v) {
#pragma unroll
    for (int o = 1; o < 64; o <<= 1) v += __shfl_xor(v, o);
    return v;
}
__device__ __forceinline__ unsigned f2bf(float f) { unsigned u = __builtin_bit_cast(unsigned, f); return (u + 0x7fffu + ((u >> 16) & 1u)) >> 16; }
__device__ __forceinline__ unsigned pk2(float lo, float hi) { return f2bf(lo) | (f2bf(hi) << 16); }

__device__ __forceinline__ int wmap_sq(int n) { const int c = n & 255; return (n & ~255) + (c & 0xe0) + 8 * ((c >> 2) & 3) + 4 * ((c >> 4) & 1) + (c & 3); }
__device__ __forceinline__ int wmap_in(int n) {
    const int pn = n >> 8, c = n & 255, wc = (c >> 5) & 3, bj = c >> 7, nn = (c >> 4) & 1, fq = (c >> 2) & 3, i = c & 3;
    const int l8 = 8 * fq + 4 * nn + i, dd = 32 * (fq >> 1) + 8 * (fq & 1) + 16 * bj + 4 * nn + i;
    if (pn < 4) return 256 * pn + 64 * wc + dd;
    if (pn == 4) return 1024 + 64 * wc + dd;
    if (pn == 5) return 1280 + 128 * bj + 32 * wc + l8;
    if (pn < 10) return 1536 + 256 * (pn - 6) + 128 * bj + 32 * wc + l8;
    if (pn < 18) return (bj ? 4608 : 2560) + 128 * (pn - 10) + 32 * wc + l8;
    if (pn < 26) return (bj ? 5632 : 3584) + 128 * (pn - 18) + 32 * wc + l8;
    return 6656 + 256 * (pn - 26) + 128 * bj + 32 * wc + l8;
}
template <bool IN> __device__ __forceinline__ void transpose_item(const float* W, int N, bf16_t* WT, LAS float* scr, int item, int lane) {
    const int nblk = N / 32, kb = item / nblk, nb = item % nblk, k0 = 64 * kb, n0 = 32 * nb;
    const int jq = lane & 7, ks = lane >> 3; const int scol = IN ? wmap_in(n0 + 4 * jq) : wmap_sq(n0 + 4 * jq);
    f32x4 wv[8];
#pragma unroll
    for (int i = 0; i < 8; ++i) wv[i] = __builtin_nontemporal_load((const f32x4*)(W + (size_t)(k0 + 8 * i + ks) * N + scol));
    if (IN && ((scol >= 1536 && scol < 2560) || (scol >= 5632 && scol < 6656))) {
#pragma unroll
        for (int i = 0; i < 8; ++i) wv[i] = wv[i] * -1.4426950408889634f; }
    asm volatile("" ::: "memory");
#pragma unroll
    for (int i = 0; i < 8; ++i) { LAS float* d = scr + (8 * i + ks) * 33 + 4 * jq; d[0] = wv[i][0]; d[1] = wv[i][1]; d[2] = wv[i][2]; d[3] = wv[i][3]; }
    LDS_WAIT(); asm volatile("" ::: "memory");
    const int c = lane & 7;
#pragma unroll
    for (int j = 0; j < 4; ++j) { const int n = (lane >> 3) + 8 * j; const LAS float* s = scr + (8 * c) * 33 + n;
        u32x4 o; o.x = pk2(s[0 * 33], s[1 * 33]); o.y = pk2(s[2 * 33], s[3 * 33]); o.z = pk2(s[4 * 33], s[5 * 33]); o.w = pk2(s[6 * 33], s[7 * 33]);
        *(GAS u32x4*)(WT + (size_t)(n0 + n) * 1024 + k0 + 8 * c) = o; }
    LDS_WAIT(); asm volatile("" ::: "memory");
}

struct Frame {
    LAS unsigned char* lds; int tid, lane, wave, vcu, G;
    unsigned char* ws; int z;
};

#ifndef ATT_THR
#define ATT_THR 8
#endif
#ifndef TAIL_A
#define TAIL_A 3
#define TAIL_B 4
#endif
__device__ __forceinline__ void p0_prologue(Frame& F, const Args& A) {
    {
        LAS float* sc = (LAS float*)(F.lds + RING_OFF);
        LAS float* red = sc + 9 * 1024;
        bool have = false;
        for (int item = F.vcu; item < 256; item += F.G) {
            const int l = item >> 7, n0 = (item & 127) * 24;
            const int q = F.tid % 6, kg = F.tid / 6;
            f32x4 wv[16]; f32x4 a[9];
            if (F.tid < 384) { const float* w = ARGP(A, I_WADA, F.z) + (size_t)l * 1024 * 3072 + n0 + 4 * q;
#pragma unroll
                for (int i = 0; i < 16; ++i) wv[i] = __builtin_nontemporal_load((const f32x4*)(w + (size_t)(kg * 16 + i) * 3072)); }
            if (!have) { const float* cp = ARGP(A, I_C, F.z); const float* cc = ARGP(A, I_CCTX, F.z); float cv[18];
#pragma unroll
                for (int q2 = 0; q2 < 18; ++q2) { const int e = F.tid + q2 * (NWAVES * 64); cv[q2] = e < 8192 ? cp[e] : cc[e - 8192]; }
                asm volatile("" ::: "memory");
#pragma unroll
                for (int q2 = 0; q2 < 18; ++q2) sc[F.tid + q2 * (NWAVES * 64)] = silu_f(cv[q2]);
                have = true; __syncthreads(); }
            if (F.tid < 384) {
#pragma unroll
                for (int j = 0; j < 9; ++j) a[j] = (f32x4){0.f, 0.f, 0.f, 0.f};
                asm volatile("" ::: "memory");
#pragma unroll
                for (int i = 0; i < 16; ++i)
#pragma unroll
                    for (int j = 0; j < 9; ++j) a[j] += wv[i] * sc[j * 1024 + kg * 16 + i];
#pragma unroll
                for (int j = 0; j < 9; ++j) *(LAS f32x4*)(red + (kg * 9 + j) * 24 + 4 * q) = a[j]; }
            __syncthreads();
            if (F.tid < 216) { const int j = F.tid / 24, col = F.tid % 24; float s = ARGP(A, I_BADA, F.z)[l * 3072 + n0 + col];
#pragma unroll 8
                for (int g = 0; g < 64; ++g) s += red[(g * 9 + j) * 24 + col];
                ((float*)(F.ws + WS_MOD))[(size_t)(l * 9 + j) * 3072 + n0 + col] = s; }
            __syncthreads();
        }
    }
    if (F.vcu == F.G - 1) { for (int e = F.tid; e < 1024; e += NWAVES * 64) { const int pos = e >> 4, j = e & 15;
            const float inv = __builtin_amdgcn_exp2f(-(float)(2 * j) * (13.287712379549449f / 32.0f)), rev = (float)pos * inv * 0.15915494309189535f;
            ((float*)(F.ws + WS_ROPEC))[e] = __builtin_amdgcn_cosf(rev); ((float*)(F.ws + WS_ROPES))[e] = __builtin_amdgcn_sinf(rev); } }
}
__device__ __forceinline__ void weight_copies(Frame& F, const Args& A, int it_lo, int it_hi, int gw, int NGW) {
    LAS float* scr = (LAS float*)(F.lds + RING_OFF + F.wave * 16384);
    constexpr int I_IN = 16 * (PROJ / 32), I_SQ = 16 * 32, PER_L = I_IN + 3 * I_SQ;
    for (int it = it_lo + gw; it < it_hi; it += NGW) {
        const int l = it / PER_L; int r = it % PER_L;
        if (r < I_IN) { transpose_item<true>(ARGP(A, I_WIN, F.z) + (size_t)l * 1024 * PROJ, PROJ, (bf16_t*)w_ptr(F.ws, l, 0), scr, r, F.lane); continue; } r -= I_IN;
        if (r < I_SQ) { transpose_item<false>(ARGP(A, I_WABR, F.z) + (size_t)l * 1024 * 1024, 1024, (bf16_t*)w_ptr(F.ws, l, 1), scr, r, F.lane); continue; } r -= I_SQ;
        if (r < I_SQ) { transpose_item<false>(ARGP(A, I_WCBR, F.z) + (size_t)l * 1024 * 1024, 1024, (bf16_t*)w_ptr(F.ws, l, 2), scr, r, F.lane); continue; } r -= I_SQ;
        transpose_item<false>(ARGP(A, I_WOUT, F.z) + (size_t)l * 1024 * 1024, 1024, (bf16_t*)w_ptr(F.ws, l, 3), scr, r, F.lane);
    }
}
constexpr int WC_IN0 = 16 * (PROJ / 32), WC_ALL = 2 * (16 * (PROJ / 32) + 3 * 16 * 32);

__device__ __forceinline__ void modulate_phase(Frame& F, const Args& A, int l, const float* xs, int rlo, int rhi, int gw, int NGW) {
    const float* mod = (const float*)(F.ws + WS_MOD) + (size_t)l * 9 * 3072; const float* ng = ARGP(A, I_NORMG, F.z) + l * 1024;
    bf16_t* HX = (bf16_t*)(F.ws + WS_HX);
    const int R = (rhi - rlo + NGW - 1) / NGW; const int ra = rlo + gw * R; int rb = ra + R; if (rb > rhi) rb = rhi;
    f32x4 Gv[4], Sv[4]; int jcur = -1;
    for (int r0 = ra; r0 < rb; r0 += 2) {
        const bool two = r0 + 1 < rb; const int rr[2] = {r0, two ? r0 + 1 : r0};
        f32x4 v[2][4]; float s[2] = {0.f, 0.f}; u32x2 w16[2][4]; const bool b16 = l && r0 < NLAT;
#pragma unroll
        for (int u = 0; u < 2; ++u) { const int r = rr[u];
            if (b16) { const u32x2* xr = (const u32x2*)((const bf16_t*)(F.ws + pg8::E_X1B) + (size_t)r * DM) + F.lane;
#pragma unroll
                for (int q = 0; q < 4; ++q) w16[u][q] = __builtin_nontemporal_load(xr + 64 * q);
            } else if (r >= NLAT && l) {
#pragma unroll
                for (int q = 0; q < 4; ++q) v[u][q] = ((const f32x4*)pg8::ctx1_half(F.ws, r - NLAT, q >> 1))[F.lane + 64 * (q & 1)];
            } else { const float* xrow = r < NLAT ? xs + (size_t)r * DM : ARGP(A, I_CTX, F.z) + (size_t)(r - NLAT) * DM; const f32x4* xr = (const f32x4*)xrow + F.lane;
#pragma unroll
                for (int q = 0; q < 4; ++q) v[u][q] = __builtin_nontemporal_load(xr + 64 * q); } }
        asm volatile("" ::: "memory");
        if (b16) {
#pragma unroll
            for (int u = 0; u < 2; ++u)
#pragma unroll
                for (int q = 0; q < 4; ++q) v[u][q] = (f32x4){__uint_as_float(w16[u][q].x << 16), __uint_as_float(w16[u][q].x & 0xffff0000u), __uint_as_float(w16[u][q].y << 16), __uint_as_float(w16[u][q].y & 0xffff0000u)}; }
#pragma unroll
        for (int u = 0; u < 2; ++u)
#pragma unroll
            for (int q = 0; q < 4; ++q) s[u] += (v[u][q].x * v[u][q].x + v[u][q].y * v[u][q].y) + (v[u][q].z * v[u][q].z + v[u][q].w * v[u][q].w);
#pragma unroll
        for (int u = 0; u < 2; ++u) { if (u == 1 && !two) break; const int r = rr[u], j = r < NLAT ? (r >> 11) : 8;
            if (j != jcur) { jcur = j;
                const f32x4* sh = (const f32x4*)(mod + (size_t)j * 3072) + F.lane; const f32x4* scl = (const f32x4*)(mod + (size_t)j * 3072 + 1024) + F.lane; const f32x4* g4 = (const f32x4*)ng + F.lane;
#pragma unroll
                for (int q = 0; q < 4; ++q) { Gv[q] = g4[64 * q] * (scl[64 * q] + 1.0f); Sv[q] = sh[64 * q]; } }
            const float rstd = __builtin_amdgcn_rsqf(wave_sum(s[u]) * (1.0f / DM) + EPS);
            unsigned long long* o8 = (unsigned long long*)(HX + (size_t)r * DM) + F.lane;
#pragma unroll
            for (int q = 0; q < 4; ++q) { const f32x4 y = v[u][q] * rstd * Gv[q] + Sv[q];
                o8[64 * q] = (unsigned long long)cvt_pk_bf16(y.x, y.y) | ((unsigned long long)cvt_pk_bf16(y.z, y.w) << 32); } }
    }
}

__device__ __forceinline__ void conv_phase(Frame& F, const Args& A, int l, int nrows) {
    const bf16_t* U = (const bf16_t*)(F.ws + e_u(l)); bf16_t* YZL = (bf16_t*)(F.ws + e_yz(l)); bf16_t* YZC = (bf16_t*)(F.ws + pg8::E_YZC) - (size_t)NLAT * DM;
    const int ch = (F.tid & 127) * 8, rg = F.tid >> 7;
    const float* cw = ARGP(A, I_CONVW, F.z) + (size_t)l * 3 * 1024 + ch; const float* cb = ARGP(A, I_CONVB, F.z) + (size_t)l * 1024 + ch;
    float w0[8], w1[8], w2[8], bb[8];
#pragma unroll
    for (int e = 0; e < 8; ++e) { w0[e] = cw[e]; w1[e] = cw[1024 + e]; w2[e] = cw[2048 + e]; bb[e] = cb[e]; }
    const int nitems = (nrows + 71) / 72;
    for (int item = F.vcu; item < nitems; item += F.G) {
        const int r0 = item * 72 + rg * 18; int r1 = r0 + 18; if (r1 > nrows) r1 = nrows;
        if (r0 >= r1) continue;
        const u32x4 z4 = {0u, 0u, 0u, 0u};
        auto seqmask = [](int r) { return r < NLAT ? (SEQ - 1) : (CTXL - 1); };
        u32x4 up = ((r0 & seqmask(r0)) != 0) ? __builtin_nontemporal_load((const u32x4*)(U + (size_t)(r0 - 1) * DM + ch)) : z4;
        u32x4 uc = __builtin_nontemporal_load((const u32x4*)(U + (size_t)r0 * DM + ch));
        for (int rb = r0; rb < r1; rb += 6) {
            u32x4 un6[6], w6[6];
#pragma unroll
            for (int q = 0; q < 6; ++q) { const int r = rb + q; const bool ok = r < r1;
                un6[q] = (ok && r + 1 < NROW) ? __builtin_nontemporal_load((const u32x4*)(U + (size_t)(r + 1) * DM + ch)) : z4;
                w6[q] = ok ? __builtin_nontemporal_load((const u32x4*)((r < NLAT ? YZL : YZC) + (size_t)r * DM + ch)) : z4; }
            asm volatile("" ::: "memory");
#pragma unroll
            for (int q = 0; q < 6; ++q) { const int r = rb + q; if (r >= r1) break;
                const int sm = seqmask(r);
                const u32x4 unr = un6[q], un = ((r & sm) != sm) ? unr : z4, wv = w6[q];
                if ((r & sm) == 0) up = z4;
                u32x4 o;
#pragma unroll
                for (int e = 0; e < 4; ++e) {
                    const float ylo = bf_lo(wv[e]) * (w0[2 * e] * bf_lo(up[e]) + w1[2 * e] * bf_lo(uc[e]) + w2[2 * e] * bf_lo(un[e]) + bb[2 * e]);
                    const float yhi = bf_hi(wv[e]) * (w0[2 * e + 1] * bf_hi(up[e]) + w1[2 * e + 1] * bf_hi(uc[e]) + w2[2 * e + 1] * bf_hi(un[e]) + bb[2 * e + 1]);
                    o[e] = cvt_pk_bf16(ylo, yhi); }
                *(u32x4*)((r < NLAT ? YZL : YZC) + (size_t)r * DM + ch) = o;
                up = uc; uc = unr; }
        }
    }
}

constexpr int CW_GRP = 8192;
__device__ __forceinline__ void group_sync(unsigned* ctl, int g, unsigned k) {
    asm volatile("s_waitcnt vmcnt(0)" ::: "memory");
    __syncthreads();
    if (threadIdx.x == 0) {
        unsigned* cnt = ctl + CW_GRP + 64 * g;
        __builtin_amdgcn_fence(__ATOMIC_RELEASE, "agent");
        asm volatile("s_waitcnt vmcnt(0)" ::: "memory");
        __hip_atomic_fetch_add(cnt, 1u, __ATOMIC_RELAXED, __HIP_MEMORY_SCOPE_AGENT);
        unsigned sp = 0;
        while (__hip_atomic_load(cnt, __ATOMIC_RELAXED, __HIP_MEMORY_SCOPE_AGENT) < 4u * k) { __builtin_amdgcn_s_sleep(2); if (++sp > (1u << 22)) break; }
        __builtin_amdgcn_fence(__ATOMIC_ACQUIRE, "agent");
        asm volatile("s_waitcnt vmcnt(0)" ::: "memory");
    }
    __syncthreads();
}

__global__ void __launch_bounds__(NWAVES * 64, 2) mk_fwd(Args args) {
    extern __shared__ __attribute__((aligned(16))) unsigned char lds[];
    { int t0 = threadIdx.x; for (int u = t0; u < (LDS_BYTES - LDSCTL_OFF) / 4; u += NWAVES * 64) ((LAS unsigned*)((LAS unsigned char*)lds + LDSCTL_OFF))[u] = 0u; }
    __syncthreads();
    XcdBarrier bar; bar.bar = (unsigned*)(args.ws + WS_CTL) + CW_BAR; bar.x = 0; bar.st = nullptr;
    if (N_LAUNCHES == 1) bar = xcd_barrier_post((unsigned*)(args.ws + WS_CTL) + CW_BAR, (volatile LAS unsigned*)((LAS unsigned char*)lds + MISC_OFF) + 8);

    int ph = args.ph_lo, sub = 0;
    while (ph < args.ph_hi) {
        int tid = threadIdx.x; asm volatile("" : "+v"(tid));
        size_t zoff = 0; asm volatile("" : "+s"(zoff));
        unsigned char* ws = args.ws + zoff; float* outp = args.out + zoff;
        Frame F; F.lds = (LAS unsigned char*)lds; F.tid = tid; F.lane = tid & 63; F.wave = __builtin_amdgcn_readfirstlane(tid >> 6);
        F.G = gridDim.x; { const int bx = blockIdx.x; F.vcu = (F.G % 8 == 0) ? (bx % 8) * (F.G / 8) + bx / 8 : bx; }
        F.ws = ws; F.z = 0; asm volatile("" : "+s"(F.z));
        const int c = (int)blockIdx.x, G = F.G; const int pl = ph >= 6 ? 1 : 0; const int plp = ph == 0 ? -1 : ph == 1 || ph == 6 ? 0 : (ph - (pl ? 7 : 2)) + 1;
        const bool tailph = (ph == 7), cx = tailph && c < 32; const int grp = c & 7, mem = c >> 3, cpm = 64 + grp;
        const bool tail = cx && sub < 3;
        const int lp = tail ? (sub == 0 ? 3 : sub == 1 ? 4 : 0) : plp;
        const int l = (tail && sub < 2) ? 0 : pl;
        const float* xs = ARGP(args, I_X, F.z);
        if (lp == -1) p0_prologue(F, args);
        else if (lp == 0) {
            if (tail) modulate_phase(F, args, 1, xs, NLAT + 256 * grp + 64 * mem, NLAT + 256 * grp + 64 * mem + 64, F.wave, NWAVES);
            else { if (!l) weight_copies(F, args, 0, WC_IN0, F.vcu * NWAVES + F.wave, F.G * NWAVES); modulate_phase(F, args, l, xs, 0, l ? NLAT : NROW, F.vcu * NWAVES + F.wave, F.G * NWAVES); }
        } else if (lp == 2) {
            const attn_body::bf16* Qp = (const attn_body::bf16*)(ws + WS_Q); const attn_body::bf16* Kp = (const attn_body::bf16*)(ws + e_k(l)); const attn_body::bf16* Vp = (const attn_body::bf16*)(ws + e_v(l));
            const attn_body::bf16* Zp = (const attn_body::bf16*)(ws + e_sza(l)); const int cslot = F.vcu & 3; int i = 0;
            bool fast; { const float gq = fabsf(ARGP(args, I_QNG, F.z)[l * 64 + F.lane]), gk = fabsf(ARGP(args, I_KNG, F.z)[l * 64 + F.lane]);
                fast = wave_max(gq) * wave_max(gk) * (0.18033688f * 64.0f * 1.02f) <= 60.0f; }
            bool pre = false; attn_body::bf16x8 qc[4];
#pragma unroll
            for (int d0 = 0; d0 < 4; ++d0) qc[d0] = (attn_body::bf16x8){0, 0, 0, 0, 0, 0, 0, 0};
            for (int id = F.vcu; id < 1024; id += F.G, ++i) { if (i == cslot) { conv_phase(F, args, l, l ? NLAT : NROW); }
                const int b = (id & 255) >> 5, h = 4 * (id >> 8) + ((id & 31) >> 3), qb = id & 7;
                const int idn = id + F.G; const bool pf = idn < 1024;
                const long nk = pf ? (long)((((idn & 255) >> 5) * 4 + (idn >> 8)) * 36) : -1;
                const long nq = ((long)((idn & 255) >> 5) * 2048 + (idn & 7) * 256) * 1024 + (4 * (idn >> 8) + ((idn & 31) >> 3)) * 64;
                if (fast) attn_body::attn_unit<ATT_THR, true>((long)b * 2048 + qb * 256, h, (long)(b * 4 + (h >> 2)) * 36, h >> 2, 36, Qp, Kp, Vp, Zp, (attn_body::bf16*)(ws + WS_Q), (char*)lds + RING_OFF, pre, nk, nq, qc);
                else attn_body::attn_unit<ATT_THR, false>((long)b * 2048 + qb * 256, h, (long)(b * 4 + (h >> 2)) * 36, h >> 2, 36, Qp, Kp, Vp, Zp, (attn_body::bf16*)(ws + WS_Q), (char*)lds + RING_OFF, pre, nk, nq, qc);
                pre = pf; }
            if (i <= cslot) { conv_phase(F, args, l, l ? NLAT : NROW); }
            if (!l) for (int id = F.vcu; id < 128; id += F.G) { const int b = id >> 4, h = id & 15;
                if (fast) attn_body::attn_unit<ATT_THR, true>((long)16384 + b * 256, h, (long)(b * 4 + (h >> 2)) * 36, h >> 2, 4, Qp, Kp, Vp, Zp, (attn_body::bf16*)(ws + WS_Q), (char*)lds + RING_OFF, false, -1, 0, qc);
                else attn_body::attn_unit<ATT_THR, false>((long)16384 + b * 256, h, (long)(b * 4 + (h >> 2)) * 36, h >> 2, 4, Qp, Kp, Vp, Zp, (attn_body::bf16*)(ws + WS_Q), (char*)lds + RING_OFF, false, -1, 0, qc); }
        } else {
            pg8::GSched S; S.base = c; S.stride = G; S.cnt = 1 << 20; S.xlast = -1; S.npre = 0; S.nx = 0; S.xpm = cpm; S.xpn = mem; S.xk0 = 0; S.xk1 = 0; S.A1 = nullptr; S.B1 = nullptr; S.pn0 = 0; S.nM = 64; S.nN = 4;
            pg8::EpiP E; E.ws = ws; E.out = outp; E.l = l; E.tab = (const LAS float*)((LAS unsigned char*)lds + EPI_TAB_OFF);
            if (lp == 1) {
                LAS float* tb = (LAS float*)((LAS unsigned char*)lds + EPI_TAB_OFF);
                { const f32x4 v = ((const f32x4*)(ws + WS_ROPEC))[tid & 255]; const f32x4 w = ((const f32x4*)(ws + WS_ROPES))[tid & 255]; if (tid < 256) ((LAS f32x4*)tb)[tid] = v; else ((LAS f32x4*)(tb + 1024))[tid - 256] = w; }
                if (tid < 32) ((LAS f32x4*)(tb + 2048))[tid] = tid < 16 ? ((const f32x4*)(ARGP(args, I_QNG, F.z) + l * 64))[tid] : ((const f32x4*)(ARGP(args, I_KNG, F.z) + l * 64))[tid - 16];
                __syncthreads(); }
            if (lp == 1) { S.mode = 0; S.nN = 34; S.nM = l ? 64 : 72; S.A0 = (const char*)(ws + WS_HX); S.B0 = (const char*)w_ptr(ws, l, 0);
                if (tailph) {
                    constexpr int TA = TAIL_A, TB = TAIL_B, TX = 160 - 16 * (TA + TB);
                    if (c >= 32) { S.base = c - 32; S.stride = G - 32; S.cnt = 9; if (c - 32 < TX) S.xlast = 2016 + (c - 32); }
                    else if (c < 16) { S.base = 2016 + TX + c; S.stride = 16; S.cnt = TA; S.npre = 1; S.xpn = 4 + mem; S.xk0 = mem ? pg8::EK_V : pg8::EK_K; }
                    else { S.base = 2016 + TX + 16 * TA + (c - 16); S.stride = 16; S.cnt = TB; } } }
            else if (lp == 3) { S.mode = 1; S.A0 = (const char*)(ws + WS_Q); S.B0 = (const char*)w_ptr(ws, l, 1); S.A1 = (const char*)(ws + e_yz(l)); S.B1 = (const char*)w_ptr(ws, l, 2);
                if (tail) { S.mode = 3; S.nx = 2; S.A0 += (size_t)cpm * pg8::TSTEP; S.B0 += (size_t)mem * pg8::TSTEP; S.A1 = (const char*)(ws + pg8::E_YZC) + (size_t)grp * pg8::TSTEP; S.B1 += (size_t)mem * pg8::TSTEP; S.xk0 = pg8::EK_BR1; S.xk1 = pg8::EK_BR2; } }
            else { S.mode = 2; S.A0 = (const char*)(ws + WS_HX); S.B0 = (const char*)w_ptr(ws, l, 3);
                if (tail) { S.mode = 3; S.nx = 1; S.A0 += (size_t)cpm * pg8::TSTEP; S.B0 += (size_t)mem * pg8::TSTEP; S.xk0 = pg8::EK_OUT; } }
            S.nwg = S.nM * S.nN;
            if (lp == 3) pg8::gemm_phase<true>(F.lds + RING_OFF, S, E, args, tid); else pg8::gemm_phase<false>(F.lds + RING_OFF, S, E, args, tid);
            if (lp == 1 && !l && G == 256 && c >= 144) weight_copies(F, args, WC_IN0, WC_ALL, (c - 144) * NWAVES + F.wave, 112 * NWAVES);
        }
        if (tail) { group_sync((unsigned*)(ws + WS_CTL), grp, (unsigned)(sub + 1)); ++sub; continue; }
        sub = 0;
        if (ph + 1 < args.ph_hi) { XcdBarrier b2 = bar; unsigned* bp = (unsigned*)(ws + WS_CTL) + CW_BAR; unsigned bx = bar.x; asm volatile("" : "+s"(bx)); b2.bar = bp; b2.x = bx; xcd_barrier(b2); }
        ++ph;
    }
}

extern "C" void kernel_launch(void* const* d_in, const int* in_sizes, int n_in, void* d_out, int out_size, void* d_ws, size_t ws_size, hipStream_t stream) {
    static int grid = 0;
    if (grid == 0) {
        if (n_in != 16 || in_sizes[0] != NLAT * DM || out_size != NLAT * DM || ws_size < WS_END) { fprintf(stderr, "kernel_launch: unexpected shapes / workspace (n_in %d, out %d, ws %zu); nothing launched\n", n_in, out_size, ws_size); grid = -1; return; }
        int dev = 0, cus = 0, per_cu = 0;
        if (hipGetDevice(&dev) != hipSuccess || hipDeviceGetAttribute(&cus, hipDeviceAttributeMultiprocessorCount, dev) != hipSuccess) { grid = -1; return; }
        if (hipFuncSetAttribute((const void*)mk_fwd, hipFuncAttributeMaxDynamicSharedMemorySize, LDS_BYTES) != hipSuccess) { fprintf(stderr, "kernel_launch: hipFuncSetAttribute failed\n"); grid = -1; return; }
        if (hipOccupancyMaxActiveBlocksPerMultiprocessor(&per_cu, (const void*)mk_fwd, NWAVES * 64, LDS_BYTES) != hipSuccess || per_cu < 1) { fprintf(stderr, "kernel_launch: occupancy query reports %d workgroups per CU\n", per_cu); (void)hipGetLastError(); grid = -1; return; }
        (void)hipGetLastError();
        if (cus != 256) { fprintf(stderr, "kernel_launch: built for a 256-CU device (the context tail's tile distribution), found %d\n", cus); grid = -1; return; }
        grid = cus;
    }
    if (grid < 0) return;
    if (hipMemsetAsync((char*)d_ws + WS_CTL, 0, CTL_ZERO_BYTES, stream) != hipSuccess) return;
    Args a{};
    for (int i = 0; i < 16; ++i) a.in[i] = (const float*)d_in[i];
    a.out = (float*)d_out; a.ws = (unsigned char*)d_ws;
    for (int li = 0; li < N_LAUNCHES; ++li) {
        a.ph_lo = (N_LAUNCHES == 1) ? 0 : li; a.ph_hi = (N_LAUNCHES == 1) ? N_PHASES : li + 1;
        hipLaunchKernelGGL(mk_fwd, dim3(grid), dim3(NWAVES * 64), LDS_BYTES, stream, a);
    }
}
```

```cpp
#include <hip/hip_runtime.h>
#include <hip/hip_bf16.h>
#include <cstdio>
#include <cstdint>

#define MK_N_LAUNCHES 1
#ifndef MK_N_LAUNCHES
#define MK_N_LAUNCHES 1
#endif

constexpr int DM = 1024, NBATCH = 8, SEQ = 2048, CTXL = 256, NLAT = NBATCH * SEQ, NCTX = NBATCH * CTXL, NROW = NLAT + NCTX;
constexpr int PROJ = 8704, KVLEN = CTXL + SEQ, KVP = 256;
constexpr float EPS = 1e-6f;
constexpr float C2 = 0.125f * 1.4426950408889634f;

struct Args { const float* in[16]; float* out; unsigned char* ws; int ph_lo, ph_hi; };
enum In { I_X = 0, I_C, I_CTX, I_CCTX, I_NORMG, I_WADA, I_BADA, I_WIN, I_QNG, I_KNG, I_CONVW, I_CONVB, I_WABR, I_WCBR, I_BGATE, I_WOUT };
#define ARGP(A, i, z) (((const __attribute__((address_space(4))) Args*)__builtin_amdgcn_kernarg_segment_ptr())->in[(i) + (z)])

#define LAS __attribute__((address_space(3)))
#define GAS __attribute__((address_space(1)))
typedef unsigned short bf16_t;
typedef short bf16x8 __attribute__((ext_vector_type(8)));
typedef float f32x4 __attribute__((ext_vector_type(4)));
typedef unsigned u32x4 __attribute__((ext_vector_type(4)));
typedef unsigned u32x2 __attribute__((ext_vector_type(2)));

typedef float f32x2_c __attribute__((ext_vector_type(2))); typedef __bf16 bf16x2_c __attribute__((ext_vector_type(2)));
__device__ __forceinline__ unsigned cvt_pk_bf16(float lo, float hi) { f32x2_c v = {lo, hi}; bf16x2_c b = __builtin_convertvector(v, bf16x2_c); return __builtin_bit_cast(unsigned, b); }
__device__ __forceinline__ float bf_lo(unsigned w) { return __uint_as_float(w << 16); }
__device__ __forceinline__ float bf_hi(unsigned w) { return __uint_as_float(w & 0xffff0000u); }
__device__ __forceinline__ float sigmoid_f(float x) { return __builtin_amdgcn_rcpf(1.0f + __expf(-x)); }
__device__ __forceinline__ float silu_f(float x) { return x * sigmoid_f(x); }
__device__ __forceinline__ float silu_ps(float a) { const float e = __builtin_amdgcn_exp2f(a); return a * __builtin_amdgcn_rcpf(__builtin_fmaf(e, -1.4426950408889634f, -1.4426950408889634f)); }
__device__ __forceinline__ u32x4 pack8(const f32x4& a, const f32x4& b) { u32x4 w; w.x = cvt_pk_bf16(a[0], a[1]); w.y = cvt_pk_bf16(a[2], a[3]); w.z = cvt_pk_bf16(b[0], b[1]); w.w = cvt_pk_bf16(b[2], b[3]); return w; }

namespace pg8 {
constexpr int BM = 256, BK = 64, HALF = 128, HTB = HALF * BK * 2, STAGE_BYTES = 8 * HTB, NXCD = 8, WGM = 3, KD = 1024;
constexpr size_t TSTEP = (size_t)BM * KD * 2;
__host__ __device__ __forceinline__ int lds_byte(int r, int c) { const int st = (r >> 4) * 2 + (c >> 5), rr = r & 15, cc = c & 31, ob = rr * 64 + cc * 2; return st * 1024 + (ob ^ (((ob >> 9) & 1) << 5)); }
__host__ __device__ __forceinline__ void stage_rc(int b, int& R, int& C) { const int st = b / 1024, sb = b % 1024, swz = sb ^ (((sb >> 9) & 1) << 5); R = (st >> 1) * 16 + swz / 64; C = (st & 1) * 32 + (swz % 64) / 2; }

struct Unit { const char* A; const char* B; int pm, pn, kind, chain; };

enum Kind { EK_Q = 0, EK_K = 1, EK_V = 2, EK_ZA = 3, EK_XC = 4, EK_BZ = 5, EK_GL = 6, EK_BR1 = 7, EK_BR2 = 8, EK_OUT = 9 };

struct GSched {
    int base, stride, cnt, xlast, npre;
    int mode  , nM, nN, pn0, nwg, nx, xpm, xpn, xk0, xk1;
    const char *A0, *A1, *B0, *B1;
    __device__ __forceinline__ bool next(int i, Unit& u) const {
        if (mode == 3) { if (i >= nx) return false; u.A = i ? A1 : A0; u.B = i ? B1 : B0; u.pm = xpm; u.pn = xpn; u.kind = i ? xk1 : xk0; u.chain = (nx == 2 && i == 0) ? 1 : 0; return true; }
        if (i < npre) { u.A = A0 + (size_t)xpm * TSTEP; u.B = B0 + (size_t)xpn * TSTEP; u.pm = xpm; u.pn = xpn; u.kind = xk0; u.chain = 0; return true; }
        i -= npre;
        const int ti = (mode == 1) ? (i >> 1) : i, seg = (mode == 1) ? (i & 1) : 0;
        if (ti > cnt || (ti == cnt && xlast < 0)) return false;
        const long L = ti == cnt ? (long)xlast : (long)base + (long)ti * stride; int pm, pn;
        if (L >= nwg) return false;
        {
            int wgid = (int)L; { const int q = nwg / NXCD, r = nwg % NXCD, xcd = wgid % NXCD, off = wgid / NXCD; wgid = (xcd < r ? xcd * (q + 1) : r * (q + 1) + (xcd - r) * q) + off; }
            const int nig = WGM * nN, gid = wgid / nig, fm = gid * WGM, gsz = (nM - fm) < WGM ? (nM - fm) : WGM;
            pm = fm + ((wgid % nig) % gsz); pn = pn0 + (wgid % nig) / gsz;
        }
        u.pm = pm; u.pn = pn;
        if (mode == 0) { u.A = A0 + (size_t)pm * TSTEP; u.B = B0 + (size_t)pn * TSTEP; u.chain = 0;
            u.kind = pn < 4 ? EK_Q : pn == 4 ? EK_K : pn == 5 ? EK_V : pn < 10 ? EK_ZA : pn < 18 ? EK_XC : pn < 26 ? EK_BZ : EK_GL; }
        else if (mode == 1) { u.A = (seg ? A1 : A0) + (size_t)pm * TSTEP; u.B = (seg ? B1 : B0) + (size_t)pn * TSTEP; u.kind = seg ? EK_BR2 : EK_BR1; u.chain = seg ? 0 : 1; }
        else { u.A = A0 + (size_t)pm * TSTEP; u.B = B0 + (size_t)pn * TSTEP; u.kind = EK_OUT; u.chain = 0; }
        return true;
    }
};

struct EpiP { unsigned char* ws; float* out; int l; const LAS float* tab; };
constexpr size_t EMiB = 1u << 20;
constexpr size_t E_MOD = 1 * EMiB, E_ROPEC = E_MOD + 256 * 1024, E_ROPES = E_ROPEC + 4096, E_HX = 48 * EMiB, E_Q = 84 * EMiB;
__device__ __forceinline__ size_t e_k(int l) { return l ? 2 * EMiB : 120 * EMiB; }
__device__ __forceinline__ size_t e_v(int l) { return l ? 11 * EMiB : 129 * EMiB; }
__device__ __forceinline__ size_t e_sza(int l) { return l ? 120 * EMiB : 138 * EMiB; }
__device__ __forceinline__ size_t e_u(int l) { return l ? 152 * EMiB : 174 * EMiB; }
__device__ __forceinline__ size_t e_yz(int l) { return l ? 184 * EMiB : 210 * EMiB; }
constexpr size_t E_GCTX = 254 * EMiB, E_X1B = 216 * EMiB, E_YZC = 250 * EMiB;
__device__ __forceinline__ float* ctx1_half(unsigned char* ws, int r, int h) { return (float*)(ws + (h ? E_GCTX : E_YZC) + (size_t)r * 2048); }
__device__ __forceinline__ unsigned char* g_rows(unsigned char* ws, float* out, int l, bool isctx, int row0) {
    return isctx ? ws + E_GCTX + (size_t)(row0 - NLAT) * 2048 : (unsigned char*)out + (size_t)row0 * 2048; }
__device__ __forceinline__ unsigned q8(float g, unsigned qmin) { unsigned q = (unsigned)(g * 255.0f + 0.5f); return q < qmin ? qmin : q; }
__device__ __forceinline__ void epilogue(const f32x4 (&acc)[2][2][4][2], const Unit& u, int wr, int wc, int fr, int fq, const EpiP& EP, const Args& AR) {
    int z = 0; asm volatile("" : "+v"(fr), "+v"(fq), "+s"(z));
    unsigned char* const ws = EP.ws; const int l = EP.l;
    struct { bf16_t *Q, *Kb, *Vb, *SZA, *U, *Wb; const float *ropec, *ropes, *mod; } P;
    P.Q = (bf16_t*)(ws + E_Q); P.Kb = (bf16_t*)(ws + e_k(l)); P.Vb = (bf16_t*)(ws + e_v(l)); P.SZA = (bf16_t*)(ws + e_sza(l)); P.U = (bf16_t*)(ws + e_u(l)); P.Wb = (bf16_t*)(ws + e_yz(l));
    P.ropec = (const float*)(ws + E_ROPEC); P.ropes = (const float*)(ws + E_ROPES); P.mod = (const float*)(ws + E_MOD) + (size_t)l * 9 * 3072;
    const int pm = u.pm, pn = u.pn; const bool isctx = pm >= 64; const int b = isctx ? pm - 64 : pm >> 3;
    const int t0 = (isctx ? 0 : (pm & 7) * 256) + wr * 64 + fr;
    const int row0 = pm * 256 + wr * 64 + fr;
    const int kind = u.kind;
    if (kind == EK_Q || kind == EK_K) {
        const bool isq = kind == EK_Q; const LAS float* gp = EP.tab + 2048 + (isq ? 0 : 64); const int dbase = 32 * (fq >> 1) + 8 * (fq & 1), jb = 8 * (fq & 1);
        f32x4 gv[2][2];
#pragma unroll
        for (int bj = 0; bj < 2; ++bj)
#pragma unroll
            for (int n = 0; n < 2; ++n) gv[bj][n] = *(const LAS f32x4*)(gp + dbase + 16 * bj + 4 * n) * (isq ? C2 : 1.0f);
#pragma unroll
        for (int ai = 0; ai < 2; ++ai)
#pragma unroll
            for (int m = 0; m < 4; ++m) {
                float ss = 0.f;
#pragma unroll
                for (int bj = 0; bj < 2; ++bj)
#pragma unroll
                    for (int n = 0; n < 2; ++n) { const f32x4 x = acc[ai][bj][m][n]; ss += (x[0] * x[0] + x[1] * x[1]) + (x[2] * x[2] + x[3] * x[3]); }
                ss += __shfl_xor(ss, 16); ss += __shfl_xor(ss, 32);
                const float rs = __builtin_amdgcn_rsqf(ss * (1.0f / 64.0f) + EPS);
                f32x4 v[2][2];
#pragma unroll
                for (int bj = 0; bj < 2; ++bj)
#pragma unroll
                    for (int n = 0; n < 2; ++n) v[bj][n] = acc[ai][bj][m][n] * rs * gv[bj][n];
                const int t = t0 + 128 * ai + 16 * m;
                if (!isctx) {
                    const int pos = (fq >> 1) ? (t & 63) : (t >> 6);
                    const LAS float* cp = EP.tab + pos * 16 + jb; const LAS float* sp = EP.tab + 1024 + pos * 16 + jb;
#pragma unroll
                    for (int n = 0; n < 2; ++n) { const f32x4 cs = *(const LAS f32x4*)(cp + 4 * n), sn = *(const LAS f32x4*)(sp + 4 * n);
                        const f32x4 a = v[0][n], bb = v[1][n]; v[0][n] = a * cs - bb * sn; v[1][n] = bb * cs + a * sn; }
                }
                const int kk = (isctx ? 0 : CTXL) + t;
                bf16_t* dst = isq ? P.Q + (size_t)(row0 + 128 * ai + 16 * m) * DM + 256 * pn + 64 * wc + dbase
                                  : P.Kb + ((((size_t)(b * 4 + wc) * 36 + (kk >> 6)) * 8 + (dbase >> 3)) * 64 + (kk & 63)) * 8;
#pragma unroll
                for (int bj = 0; bj < 2; ++bj) *(u32x4*)(dst + (isq ? 16 : 1024) * bj) = pack8(v[bj][0], v[bj][1]);
                asm volatile("" ::: "memory");
            }
    } else if (kind == EK_V) {
#pragma unroll
        for (int ai = 0; ai < 2; ++ai)
#pragma unroll
            for (int m = 0; m < 4; ++m) { const int kk = (isctx ? 0 : CTXL) + t0 + 128 * ai + 16 * m;
#pragma unroll
                for (int bj = 0; bj < 2; ++bj) { bf16_t* dst = P.Vb + ((((size_t)(b * 4 + 2 * bj + (wc >> 1)) * 36 + (kk >> 6)) * 2 + (wc & 1)) * 64 + (kk & 63)) * 32 + 8 * fq;
                    *(u32x4*)dst = pack8(acc[ai][bj][m][0], acc[ai][bj][m][1]); } }
    } else if (kind == EK_ZA) {
#pragma unroll
        for (int ai = 0; ai < 2; ++ai)
#pragma unroll
            for (int m = 0; m < 4; ++m) { bf16_t* dst = P.SZA + (size_t)(row0 + 128 * ai + 16 * m) * DM + 256 * (pn - 6) + 32 * wc + 8 * fq;
#pragma unroll
                for (int bj = 0; bj < 2; ++bj) { f32x4 a = acc[ai][bj][m][0], c = acc[ai][bj][m][1];
#pragma unroll
                    for (int i = 0; i < 4; ++i) { a[i] = silu_ps(a[i]); c[i] = silu_ps(c[i]); }
                    *(u32x4*)(dst + 128 * bj) = pack8(a, c); } }
    } else if (kind == EK_XC) {
#pragma unroll
        for (int ai = 0; ai < 2; ++ai)
#pragma unroll
            for (int m = 0; m < 4; ++m) { bf16_t* dst = P.U + (size_t)(row0 + 128 * ai + 16 * m) * DM + 128 * (pn - 10) + 32 * wc + 8 * fq;
                *(u32x4*)dst = pack8(acc[ai][0][m][0] * acc[ai][1][m][0], acc[ai][0][m][1] * acc[ai][1][m][1]); }
    } else if (kind == EK_BZ) {
#pragma unroll
        for (int ai = 0; ai < 2; ++ai)
#pragma unroll
            for (int m = 0; m < 4; ++m) { bf16_t* dst = (isctx ? (bf16_t*)(ws + E_YZC) - (size_t)NLAT * DM : P.Wb) + (size_t)(row0 + 128 * ai + 16 * m) * DM + 128 * (pn - 18) + 32 * wc + 8 * fq;
                f32x4 a = acc[ai][1][m][0], c = acc[ai][1][m][1];
#pragma unroll
                for (int i = 0; i < 4; ++i) { a[i] = silu_ps(a[i]); c[i] = silu_ps(c[i]); }
                *(u32x4*)dst = pack8(acc[ai][0][m][0] * a, acc[ai][0][m][1] * c); }
    } else if (kind == EK_GL) {
        unsigned char* gb = g_rows(ws, EP.out, l, isctx, row0);
        const int col = 256 * (pn - 26) + 32 * wc + 8 * fq; const float qminf = pn >= 30 ? 1.0f : 0.0f;
        const float* bgp = ARGP(AR, I_BGATE, z) + l * 2048;
        f32x4 bv[2][2];
#pragma unroll
        for (int bj = 0; bj < 2; ++bj)
#pragma unroll
            for (int n = 0; n < 2; ++n) bv[bj][n] = *(const f32x4*)(bgp + col + 128 * bj + 4 * n) * -1.4426950408889634f;
        auto q4 = [&](const f32x4& x, const f32x4& bc) -> unsigned { float t[4];
#pragma unroll
            for (int i = 0; i < 4; ++i) { const float e = __builtin_amdgcn_exp2f(__builtin_fmaf(x[i], -1.4426950408889634f, bc[i]));
                const float r = __builtin_fmaxf(__builtin_amdgcn_rcpf(__builtin_fmaf(e, 1.0f / 255.0f, 1.0f / 255.0f)), qminf); t[i] = r + 8388608.0f; }
            return __builtin_amdgcn_perm(__float_as_uint(t[1]), __float_as_uint(t[0]), 0x0c0c0400u) | __builtin_amdgcn_perm(__float_as_uint(t[3]), __float_as_uint(t[2]), 0x04000c0cu); };
#pragma unroll
        for (int ai = 0; ai < 2; ++ai)
#pragma unroll
            for (int m = 0; m < 4; ++m) { unsigned char* dst = gb + (size_t)(128 * ai + 16 * m) * 2048 + col;
#pragma unroll
                for (int bj = 0; bj < 2; ++bj) { u32x2 w; w.x = q4(acc[ai][bj][m][0], bv[bj][0]); w.y = q4(acc[ai][bj][m][1], bv[bj][1]);
                    *(u32x2*)(dst + 128 * bj) = w; } }
    } else {
        const int col = 256 * pn + 32 * wc + 8 * fq; const float* gp = P.mod + (size_t)(isctx ? 8 : b) * 3072 + 2048 + col;
        f32x4 gv[2][2];
#pragma unroll
        for (int bj = 0; bj < 2; ++bj)
#pragma unroll
            for (int n = 0; n < 2; ++n) gv[bj][n] = *(const f32x4*)(gp + 128 * bj + 4 * n) * (1.0f / 255.0f);
        const bool rb16 = l && !isctx, wb16 = !l && !isctx;
        const bf16_t* X1B = (const bf16_t*)(ws + E_X1B) + (size_t)row0 * DM + col;
        const float* src = isctx ? ARGP(AR, I_CTX, z) + (size_t)(row0 - NLAT) * DM + col : ARGP(AR, I_X, z) + (size_t)row0 * DM + col;
        float* dst = isctx ? ctx1_half(ws, row0 - NLAT, pn >> 1) + (col & 511) : EP.out + (size_t)row0 * DM + col;
        const size_t dpitch = isctx ? 512 : DM;
        u32x4 xb[3][2][2];
#define OUT_LOAD(G) do { const size_t rn = (size_t)(128 * ((G) >> 2) + 16 * ((G) & 3)) * DM; \
            _Pragma("unroll") for (int bj = 0; bj < 2; ++bj) { \
                if (rb16) xb[(G) % 3][bj][0] = __builtin_nontemporal_load((const u32x4*)(X1B + rn + 128 * bj)); \
                else { _Pragma("unroll") for (int n = 0; n < 2; ++n) xb[(G) % 3][bj][n] = *(const u32x4*)(src + rn + 128 * bj + 4 * n); } } } while (0)
        OUT_LOAD(0); OUT_LOAD(1);
#pragma unroll
        for (int g = 0; g < 8; ++g) { const int ai = g >> 2, m = g & 3;
            if (g + 2 < 8) OUT_LOAD(g + 2);
#pragma unroll
            for (int bj = 0; bj < 2; ++bj) { f32x4 xa, xc; const u32x4 r0 = xb[g % 3][bj][0], r1 = xb[g % 3][bj][1];
                if (rb16) { xa = (f32x4){__uint_as_float(r0.x << 16), __uint_as_float(r0.x & 0xffff0000u), __uint_as_float(r0.y << 16), __uint_as_float(r0.y & 0xffff0000u)};
                            xc = (f32x4){__uint_as_float(r0.z << 16), __uint_as_float(r0.z & 0xffff0000u), __uint_as_float(r0.w << 16), __uint_as_float(r0.w & 0xffff0000u)}; }
                else { xa = __builtin_bit_cast(f32x4, r0); xc = __builtin_bit_cast(f32x4, r1); }
                xa = xa + gv[bj][0] * acc[ai][bj][m][0]; xc = xc + gv[bj][1] * acc[ai][bj][m][1];
                if (wb16) *(u32x4*)((bf16_t*)(ws + E_X1B) + (size_t)(row0 + 128 * ai + 16 * m) * DM + col + 128 * bj) = pack8(xa, xc);
                else { float* d = dst + (size_t)(128 * ai + 16 * m) * dpitch + 128 * bj; *(f32x4*)d = xa; *(f32x4*)(d + 4) = xc; } }
            asm volatile("" ::: "memory"); }
#undef OUT_LOAD
    }
}

__device__ __forceinline__ void chain_update(f32x4 (&acc)[2][2][4][2], const Unit& u, int wr, int wc, int fr, int fq, const EpiP& EP) {
    asm volatile("" : "+v"(fr), "+v"(fq));
    const bool br1 = u.kind == EK_BR1;
    const int pm = u.pm, pn = u.pn; const bool isctx = pm >= 64; const int row0 = pm * 256 + wr * 64 + fr;
    const unsigned char* gb = g_rows(EP.ws, EP.out, EP.l, isctx, row0);
    bf16_t* MRG = (bf16_t*)(EP.ws + E_HX);
    const int col = 256 * pn + 32 * wc + 8 * fq;
    u32x2 w1b[2][2], w0b[2][2];
#pragma unroll
    for (int bj = 0; bj < 2; ++bj) { w1b[0][bj] = *(const u32x2*)(gb + col + 1024 + 128 * bj); if (br1) w0b[0][bj] = *(const u32x2*)(gb + col + 128 * bj); else w0b[0][bj] = (u32x2){0u, 0u}; }
#pragma unroll
    for (int g = 0; g < 8; ++g) { const int ai = g >> 2, m = g & 3;
        if (g + 1 < 8) { const unsigned char* gn = gb + (size_t)(128 * ((g + 1) >> 2) + 16 * ((g + 1) & 3)) * 2048 + col;
#pragma unroll
            for (int bj = 0; bj < 2; ++bj) { w1b[(g + 1) & 1][bj] = *(const u32x2*)(gn + 1024 + 128 * bj); if (br1) w0b[(g + 1) & 1][bj] = *(const u32x2*)(gn + 128 * bj); else w0b[(g + 1) & 1][bj] = (u32x2){0u, 0u}; } }
#pragma unroll
        for (int bj = 0; bj < 2; ++bj) {
            const u32x2 w1 = w1b[g & 1][bj], w0 = w0b[g & 1][bj];
            const f32x4 g1a = {(float)(w1.x & 255u), (float)((w1.x >> 8) & 255u), (float)((w1.x >> 16) & 255u), (float)(w1.x >> 24)}, g1b = {(float)(w1.y & 255u), (float)((w1.y >> 8) & 255u), (float)((w1.y >> 16) & 255u), (float)(w1.y >> 24)};
            f32x4 ra, rb;
            if (br1) {
                const f32x4 g0a = {(float)(w0.x & 255u), (float)((w0.x >> 8) & 255u), (float)((w0.x >> 16) & 255u), (float)(w0.x >> 24)}, g0b = {(float)(w0.y & 255u), (float)((w0.y >> 8) & 255u), (float)((w0.y >> 16) & 255u), (float)(w0.y >> 24)};
#pragma unroll
                for (int i = 0; i < 4; ++i) { ra[i] = g0a[i] * __builtin_amdgcn_rcpf(g1a[i]); rb[i] = g0b[i] * __builtin_amdgcn_rcpf(g1b[i]); }
            } else {
                *(u32x4*)(MRG + (size_t)(row0 + 128 * ai + 16 * m) * DM + col + 128 * bj) = pack8(acc[ai][bj][m][0] * g1a, acc[ai][bj][m][1] * g1b);
                ra = rb = (f32x4){0.f, 0.f, 0.f, 0.f};
            }
            asm volatile("" : "+v"(ra), "+v"(rb));
            acc[ai][bj][m][0] = acc[ai][bj][m][0] * ra; acc[ai][bj][m][1] = acc[ai][bj][m][1] * rb;
            asm volatile("" : "+v"(acc[ai][bj][m][0]), "+v"(acc[ai][bj][m][1])); }
        asm volatile("" ::: "memory"); }
}

__device__ __forceinline__ void glds16_sb(const void* sbase, unsigned voff, unsigned lds_dst) {
    asm volatile("s_mov_b32 m0, %1\n\ts_nop 0\n\tglobal_load_lds_dwordx4 %0, %2" :: "v"(voff), "s"(lds_dst), "s"(sbase) : "memory", "m0"); }
template <bool CHAIN> __device__ __forceinline__ void gemm_phase(LAS unsigned char* lds, const GSched& S, const EpiP& E, const Args& AR, int tid) {
    const int wid = __builtin_amdgcn_readfirstlane(tid >> 6), lane = tid & 63, wr = wid >> 2, wc = wid & 3, fr = lane & 15, fq = lane >> 4;
    constexpr int K = KD, nt = K / BK;
    unsigned voffA[2];
#pragma unroll
    for (int i = 0; i < 2; ++i) { int R, C; stage_rc(tid * 16 + i * 8192, R, C); voffA[i] = (unsigned)(R * K + C) * 2u; }
    const size_t kstep = (size_t)(BK * 2);
    const size_t hstep = (size_t)HALF * K * 2;
    const unsigned ldsw = (unsigned)wid * 1024u;
    const int aoff = lds_byte(wr * 64 + fr, fq * 8), boff = lds_byte(wc * 32 + fr, fq * 8);
#define PG8_SA(b, h) (((b) * 2 + (h)) * HTB)
#define PG8_SB(b, h) ((4 + (b) * 2 + (h)) * HTB)
    const unsigned ldsb = (unsigned)(uintptr_t)lds;
#define PG8_STAGE(bufoff, gbase) do { _Pragma("unroll") for (int _i = 0; _i < 2; ++_i) glds16_sb((const char*)(gbase), voffA[_i], (unsigned)__builtin_amdgcn_readfirstlane(ldsb + (bufoff) + ldsw + _i * 8192)); } while (0)
#define PG8_LDA(dst, b, h) do { _Pragma("unroll") for (int m = 0; m < 4; ++m) _Pragma("unroll") for (int k = 0; k < 2; ++k) dst[m][k] = *(const LAS bf16x8*)(lds + PG8_SA(b, h) + aoff + m * 2048 + k * 1024); } while (0)
#define PG8_LDB(dst, b, h) do { _Pragma("unroll") for (int n = 0; n < 2; ++n) _Pragma("unroll") for (int k = 0; k < 2; ++k) dst[n][k] = *(const LAS bf16x8*)(lds + PG8_SB(b, h) + boff + n * 2048 + k * 1024); } while (0)
#define PG8_MMA(ai, bj, At, Bt) do { __builtin_amdgcn_s_setprio(1); _Pragma("unroll") for (int m = 0; m < 4; ++m) _Pragma("unroll") for (int n = 0; n < 2; ++n) _Pragma("unroll") for (int k = 0; k < 2; ++k) \
        acc[ai][bj][m][n] = __builtin_amdgcn_mfma_f32_16x16x32_bf16(Bt[n][k], At[m][k], acc[ai][bj][m][n], 0, 0, 0); __builtin_amdgcn_s_setprio(0); } while (0)
#define PG8_WAIT_V(n) asm volatile("s_waitcnt vmcnt(" #n ")" ::: "memory")
#define PG8_WAIT_L(n) asm volatile("s_waitcnt lgkmcnt(" #n ")" ::: "memory")
#define PG8_BAR __builtin_amdgcn_s_barrier()
#define PG8_SCHED __builtin_amdgcn_sched_barrier(0)
    Unit cur, nxt; int ui = 0;
    if (!S.next(0, cur)) return;
    f32x4 acc[2][2][4][2];
#pragma unroll
    for (int a = 0; a < 2; ++a)
#pragma unroll
        for (int b = 0; b < 2; ++b)
#pragma unroll
            for (int m = 0; m < 4; ++m)
#pragma unroll
                for (int n = 0; n < 2; ++n) acc[a][b][m][n] = (f32x4){0.f, 0.f, 0.f, 0.f};
    bf16x8 At[4][2], B0[2][2], B1[2][2];
    const char* cA = cur.A; const char* cB = cur.B;
    PG8_STAGE(PG8_SB(0, 0), cB); PG8_STAGE(PG8_SB(0, 1), cB + hstep); PG8_STAGE(PG8_SA(0, 0), cA); PG8_STAGE(PG8_SA(0, 1), cA + hstep);
    if (wr == 1) PG8_BAR;
    PG8_WAIT_V(2); PG8_BAR;
    PG8_STAGE(PG8_SB(1, 0), cB + kstep); PG8_STAGE(PG8_SA(1, 0), cA + kstep); PG8_STAGE(PG8_SB(1, 1), cB + hstep + kstep);
    PG8_WAIT_V(6); PG8_BAR;
    for (;;) {
        const bool has_next = S.next(ui + 1, nxt);
        const char* nA = has_next ? nxt.A : cA; const char* nB = has_next ? nxt.B : cB;
        for (int t = 0; t < nt; t += 2) {
            const bool last = (t == nt - 2);
            const char* a1 = cA + (size_t)(t + 1) * kstep;
            const char* a2 = last ? nA : cA + (size_t)(t + 2) * kstep; const char* b2 = last ? nB : cB + (size_t)(t + 2) * kstep;
            const char* a3 = a2 + kstep; const char* b3 = b2 + kstep;
            PG8_LDB(B0, 0, 0); PG8_LDB(B1, 0, 1); PG8_SCHED; PG8_LDA(At, 0, 0); PG8_STAGE(PG8_SA(1, 1), a1 + hstep);
            PG8_WAIT_V(8); PG8_WAIT_L(0); PG8_BAR; PG8_MMA(0, 0, At, B0); PG8_MMA(0, 1, At, B1); PG8_BAR; PG8_SCHED;
            PG8_LDA(At, 0, 1); PG8_STAGE(PG8_SB(0, 0), b2); PG8_STAGE(PG8_SB(0, 1), b2 + hstep); PG8_STAGE(PG8_SA(0, 0), a2);
            PG8_WAIT_V(8); PG8_WAIT_L(0); PG8_BAR; PG8_MMA(1, 0, At, B0); PG8_MMA(1, 1, At, B1); PG8_BAR; PG8_SCHED;
            PG8_LDB(B0, 1, 0); PG8_LDB(B1, 1, 1); PG8_SCHED; PG8_LDA(At, 1, 0); PG8_STAGE(PG8_SA(0, 1), a2 + hstep);
            PG8_WAIT_V(8); PG8_WAIT_L(0); PG8_BAR; PG8_MMA(0, 0, At, B0); PG8_MMA(0, 1, At, B1); PG8_BAR; PG8_SCHED;
            PG8_LDA(At, 1, 1); PG8_STAGE(PG8_SB(1, 0), b3); PG8_STAGE(PG8_SB(1, 1), b3 + hstep); PG8_STAGE(PG8_SA(1, 0), a3);
            PG8_WAIT_V(8); PG8_WAIT_L(0); PG8_BAR; PG8_MMA(1, 0, At, B0); PG8_MMA(1, 1, At, B1); PG8_BAR; PG8_SCHED;
        }
        if (wr == 0) PG8_BAR;
        if constexpr (CHAIN) chain_update(acc, cur, wr, wc, fr, fq, E);
        else {
            epilogue(acc, cur, wr, wc, fr, fq, E, AR);
#pragma unroll
            for (int a = 0; a < 2; ++a)
#pragma unroll
                for (int b = 0; b < 2; ++b)
#pragma unroll
                    for (int m = 0; m < 4; ++m)
#pragma unroll
                        for (int n = 0; n < 2; ++n) acc[a][b][m][n] = (f32x4){0.f, 0.f, 0.f, 0.f};
        }
        if (!has_next) break;
        cur = nxt; cA = nA; cB = nB; ++ui;
        if (wr == 1) PG8_BAR;
    }
    PG8_WAIT_V(0);
    PG8_BAR;
#undef PG8_SA
#undef PG8_SB
#undef PG8_STAGE
#undef PG8_LDA
#undef PG8_LDB
#undef PG8_MMA
#undef PG8_WAIT_V
#undef PG8_WAIT_L
#undef PG8_BAR
#undef PG8_SCHED
}
}
namespace attn_body {
using bf16=__hip_bfloat16;
using bf16x8=__attribute__((ext_vector_type(8)))short;
using s16x4=__attribute__((ext_vector_type(4)))short;
using f32x16=__attribute__((ext_vector_type(16)))float;
using u32x4=__attribute__((ext_vector_type(4)))unsigned;
constexpr int D=64,QP=1024,KP=256;
constexpr int NW=8,QBLK=32,QB=QBLK*NW,KVBLK=64;
__device__ __forceinline__ int crow(int r,int hi){return (r&3)+8*(r>>2)+4*hi;}
#define SBAR() __builtin_amdgcn_sched_barrier(0)
constexpr int NSLOT=3, SLOTB=8192;
constexpr int LDS_K=0, LDS_V=NSLOT*SLOTB, LDS_WS=2*NSLOT*SLOTB, LDS_OST=LDS_WS+NW*64*4, LDS_ZST=LDS_OST+NW*4096, LDS_BYTES=LDS_ZST+NW*4096;
__device__ __forceinline__ void glds16(const void*gsrc,unsigned lds_dst){unsigned keep;
  asm volatile("s_mov_b32 %0, m0\n\ts_mov_b32 m0, %2\n\ts_nop 0\n\tglobal_load_lds_dwordx4 %1, off\n\ts_mov_b32 m0, %0":"=&s"(keep):"v"(gsrc),"s"(lds_dst):"memory");}
__device__ __forceinline__ void glds16s(const void*sbase,unsigned voff,unsigned lds_dst){
  asm volatile("s_mov_b32 m0, %1\n\ts_nop 0\n\tglobal_load_lds_dwordx4 %0, %2"::"v"(voff),"s"(lds_dst),"s"(sbase):"memory","m0");}
__device__ __forceinline__ float max3f(float a,float b,float c){float r;asm("v_max3_f32 %0, %1, %2, %3":"=v"(r):"v"(a),"v"(b),"v"(c));return r;}
__device__ __forceinline__ float max2f(float a,float b){float r;asm("v_max_f32_e32 %0, %1, %2":"=v"(r):"v"(a),"v"(b));return r;}
__device__ __forceinline__ float fadd_s(float a,float b){float r;asm("v_add_f32_e32 %0, %1, %2":"=v"(r):"v"(a),"v"(b));return r;}
__device__ __forceinline__ float fsub_s(float a,float b){float r;asm("v_sub_f32_e32 %0, %1, %2":"=v"(r):"v"(a),"v"(b));return r;}
typedef float f32x2_t __attribute__((ext_vector_type(2))); typedef __bf16 bf16x2_t __attribute__((ext_vector_type(2)));
__device__ __forceinline__ unsigned cvtpk_s(float lo,float hi){f32x2_t v={lo,hi};bf16x2_t b=__builtin_convertvector(v,bf16x2_t);return __builtin_bit_cast(unsigned,b);}
#define WAIT_BAR(N) asm volatile("s_waitcnt vmcnt(" #N ") lgkmcnt(0)\n\ts_barrier":::"memory")

__device__ __forceinline__ void qkt(f32x16&p0,f32x16&p1,const char*Kslot,const bf16x8*qr,const f32x16&negm,int r32,int hi){
  const char*kb=Kslot+hi*1024+r32*16;
  #pragma unroll
  for(int d0=0;d0<4;++d0){
    const bf16x8 b0=*reinterpret_cast<const bf16x8*>(kb+d0*2048);
    const bf16x8 b1=*reinterpret_cast<const bf16x8*>(kb+d0*2048+512);
    if(d0==0){p0=__builtin_amdgcn_mfma_f32_32x32x16_bf16(b0,qr[0],negm,0,0,0);p1=__builtin_amdgcn_mfma_f32_32x32x16_bf16(b1,qr[0],negm,0,0,0);}
    else{p0=__builtin_amdgcn_mfma_f32_32x32x16_bf16(b0,qr[d0],p0,0,0,0);p1=__builtin_amdgcn_mfma_f32_32x32x16_bf16(b1,qr[d0],p1,0,0,0);}}
}
typedef __attribute__((address_space(3))) const char* lds_cptr;
typedef short v4i16_t __attribute__((ext_vector_type(4)));
__device__ __forceinline__ void kload8(bf16x8*kf,lds_cptr kp){
  kf[0]=*(const __attribute__((address_space(3))) bf16x8*)(kp);      kf[1]=*(const __attribute__((address_space(3))) bf16x8*)(kp+512);
  kf[2]=*(const __attribute__((address_space(3))) bf16x8*)(kp+2048); kf[3]=*(const __attribute__((address_space(3))) bf16x8*)(kp+2560);
  kf[4]=*(const __attribute__((address_space(3))) bf16x8*)(kp+4096); kf[5]=*(const __attribute__((address_space(3))) bf16x8*)(kp+4608);
  kf[6]=*(const __attribute__((address_space(3))) bf16x8*)(kp+6144); kf[7]=*(const __attribute__((address_space(3))) bf16x8*)(kp+6656);
}
__device__ __forceinline__ void kload2(bf16x8*kf,lds_cptr kp,int j){ kf[2*j]=*(const __attribute__((address_space(3))) bf16x8*)(kp+j*2048); kf[2*j+1]=*(const __attribute__((address_space(3))) bf16x8*)(kp+j*2048+512); }
__device__ __forceinline__ s16x4 vtr(lds_cptr p){ return __builtin_bit_cast(s16x4,__builtin_amdgcn_ds_read_tr16_b64_v4i16((__attribute__((address_space(3))) v4i16_t*)p)); }
__device__ __forceinline__ float rowmax(const f32x16&p0,const f32x16&p1){
  float a=max3f(p0[0],p0[1],p1[0]),b=max3f(p0[2],p0[3],p1[1]);a=max3f(a,p1[2],p1[3]);
  #pragma unroll
  for(int r=4;r<16;r+=4){a=max3f(a,p0[r],p0[r+1]);b=max3f(b,p0[r+2],p0[r+3]);a=max3f(a,p1[r],p1[r+1]);b=max3f(b,p1[r+2],p1[r+3]);}
  const float m=max2f(a,b);
  auto rr=__builtin_amdgcn_permlane32_swap(__float_as_uint(m),__float_as_uint(m),false,false);
  return max2f(__uint_as_float(rr[0]),__uint_as_float(rr[1]));
}
__device__ __forceinline__ void pv(f32x16*o,int vb,bf16x8 pa0,bf16x8 pa1,bf16x8 pa2,bf16x8 pa3){
  #pragma unroll
  for(int d0=0;d0<2;++d0){s16x4 lo[4],hi[4];
    #pragma unroll
    for(int ks=0;ks<4;++ks){
      asm volatile("ds_read_b64_tr_b16 %0,%1 offset:%c2":"=&v"(lo[ks]):"v"(vb),"i"(d0*4096+ks*1024):"memory");
      asm volatile("ds_read_b64_tr_b16 %0,%1 offset:%c2":"=&v"(hi[ks]):"v"(vb),"i"(d0*4096+ks*1024+512):"memory");}
    asm volatile("s_waitcnt lgkmcnt(0)":::"memory");SBAR();
    #define PK(k) (bf16x8){lo[k][0],lo[k][1],lo[k][2],lo[k][3],hi[k][0],hi[k][1],hi[k][2],hi[k][3]}
    o[d0]=__builtin_amdgcn_mfma_f32_32x32x16_bf16(pa0,PK(0),o[d0],0,0,0);
    o[d0]=__builtin_amdgcn_mfma_f32_32x32x16_bf16(pa1,PK(1),o[d0],0,0,0);
    o[d0]=__builtin_amdgcn_mfma_f32_32x32x16_bf16(pa2,PK(2),o[d0],0,0,0);
    o[d0]=__builtin_amdgcn_mfma_f32_32x32x16_bf16(pa3,PK(3),o[d0],0,0,0);
    #undef PK
  }
}

#ifndef ATTN_STORE16
#define ATTN_STORE16(p,v) (*(u32x4*)(p)=(v))
#endif
template<int THRL,bool NOMAX> __device__ __forceinline__ void attn_unit(long qrow0,int h,long krow0,int kvh,int NT,const bf16*Q,const bf16*__restrict__ K,const bf16*__restrict__ V,const bf16*__restrict__ SZ,bf16*O,char*shm,bool pre,long nk,long nq,bf16x8(&qc)[4]){
  int tid=threadIdx.x; asm volatile("":"+v"(tid)); const int lane=tid&63,r32=lane&31,hi=lane>>5; const int wid=__builtin_amdgcn_readfirstlane(tid>>6);
  const bf16*Qw=Q+(qrow0+wid*QBLK)*QP+h*D;
  const bf16*Kh=K+krow0*4096,*Vh=V+krow0*4096;
  const unsigned lds0=(unsigned)(uintptr_t)shm;
  float*wsf=(float*)(shm+LDS_WS)+wid*64;
  const unsigned kvoff=(unsigned)(wid*512+lane*8)*2u;
  const unsigned kdst=lds0+LDS_K+wid*1024, vdst=lds0+LDS_V+wid*1024;
  #define DMA_K(t,slot) glds16s(Kh+(long)(t)*4096,kvoff,(unsigned)__builtin_amdgcn_readfirstlane(kdst+(slot)))
  #define DMA_V(t,slot) glds16s(Vh+(long)(t)*4096,kvoff,(unsigned)__builtin_amdgcn_readfirstlane(vdst+(slot)))
  const int vb0=(int)(lds0+LDS_V)+((lane>>4)&1)*32+(lane&3)*8+(4*hi+((lane&15)>>2))*64;
  const char*Kbase=shm+LDS_K; bf16x8 kf[8];
  const lds_cptr shm3=(lds_cptr)shm; const lds_cptr kp0=shm3+LDS_K+hi*1024+r32*16; const lds_cptr vp0=shm3+LDS_V+((lane>>4)&1)*32+(lane&3)*8+(4*hi+((lane&15)>>2))*64;
  if(!pre){DMA_K(0,0);DMA_V(0,0);DMA_K(1,SLOTB);}
  bf16x8 qr[4];
  if(!pre){
    #pragma unroll
    for(int d0=0;d0<4;++d0)qr[d0]=*reinterpret_cast<const bf16x8*>(&Qw[(long)r32*QP+d0*16+hi*8]); }
  else{
    #pragma unroll
    for(int d0=0;d0<4;++d0)qr[d0]=qc[d0]; }
  float mhat=0.f,l_reg=0.f;
  typedef __attribute__((ext_vector_type(4))) float f32x4_t; f32x4_t lsum={0.f,0.f,0.f,0.f};
  const short one_=((((lane&15)<8)?0:1)==((lane>>4)&1))?(short)0x3F80:(short)0; bf16x8 onesA={one_,one_,one_,one_,one_,one_,one_,one_}; if constexpr(NOMAX)asm volatile("":"+v"(onesA));
  f32x16 o[2];o[0]=f32x16{};o[1]=f32x16{};f32x16 negm=f32x16{};if constexpr(!NOMAX)asm volatile("":"+v"(negm));
  #define CMASK(P0,P1,t) do{}while(0)
  bool resc=false;
  #define START(P0,P1) do{ resc=false; \
    if constexpr(!NOMAX){ const float rm=rowmax(P0,P1); const float dl=rm; mhat=fadd_s(mhat,dl); \
      _Pragma("unroll") for(int r=0;r<16;++r){P0[r]=fsub_s(P0[r],dl);P1[r]=fsub_s(P1[r],dl);} \
      _Pragma("unroll") for(int r=0;r<16;++r)negm[r]=-mhat; asm volatile("":"+v"(negm)); } \
    _Pragma("unroll") for(int r=0;r<16;++r)P0[r]=__builtin_amdgcn_exp2f(P0[r]); }while(0)
  #define RESC() do{ if constexpr(!NOMAX) if(resc){ asm volatile("s_waitcnt lgkmcnt(0)":::"memory"); \
      _Pragma("unroll") for(int d_=0;d_<2;++d_) _Pragma("unroll") for(int r=0;r<16;++r)o[d_][r]*=wsf[crow(r,hi)]; } }while(0)
  f32x16 pA0,pA1,pB0,pB1;
  int sl_prev=0,sl_cur=0,sl_next=SLOTB;
  #define ROT() do{sl_prev=sl_cur;sl_cur=sl_next;sl_next=(sl_next==(NSLOT-1)*SLOTB)?0:sl_next+SLOTB;}while(0)
  if(!pre){DMA_K(2,2*SLOTB);}
  if(pre){WAIT_BAR(4);}
  else{WAIT_BAR(3);}
  qkt(pA0,pA1,Kbase,qr,negm,r32,hi);asm volatile("s_nop 15\n\ts_nop 7":"+v"(pA0),"+v"(pA1));CMASK(pA0,pA1,0);
  START(pA0,pA1);
  _Pragma("unroll") for(int r=0;r<16;++r)pA1[r]=__builtin_amdgcn_exp2f(pA1[r]);
  WAIT_BAR(0);
  DMA_K(3,0);DMA_V(1,SLOTB);
  ROT();
  kload8(kf,kp0+sl_cur);
  WAIT_BAR(2);
  { const bf16*Zw=SZ+(qrow0+wid*QBLK)*QP+h*D;
    #pragma unroll
    for(int i=0;i<4;++i)glds16(Zw+(long)(i*8+(lane>>3))*QP+(lane&7)*8,(unsigned)__builtin_amdgcn_readfirstlane(lds0+LDS_ZST+wid*4096+i*1024)); }
  s16x4 vlo[8],vhi[8]; u32x4 pw0,pw1,pw2,pw3;
  #define PKW(P,B) cvtpk_s(P[B],P[B+1])
  #define PAF(k) __builtin_bit_cast(bf16x8,pw##k)
  #define VFR(i) (bf16x8){vlo[i][0],vlo[i][1],vlo[i][2],vlo[i][3],vhi[i][0],vhi[i][1],vhi[i][2],vhi[i][3]}
  #define PIN(x) asm volatile("":"+v"(x))
  #define MX3(a,b,c) __builtin_fmaxf(__builtin_fmaxf((a),(b)),(c))
  #define GAPA(MF,A0,A1,A2,A3,W0,W1,PW) do{ MF; if constexpr(!NOMAX){ sacc+=A0; sacc+=A1; sacc+=A2; sacc+=A3; PIN(sacc); } W0; W1; PIN(PW); SBAR(); }while(0)
  #define GAPA2(MF,A0,A1,W0,W1,PW) do{ MF; if constexpr(!NOMAX){ sacc+=A0; sacc+=A1; PIN(sacc); } W0; W1; PIN(PW); SBAR(); }while(0)
  #define LSUM(k) do{ if constexpr(NOMAX){ lsum=__builtin_amdgcn_mfma_f32_16x16x32_bf16(onesA,PAF(k),lsum,0,0,0); SBAR(); } }while(0)
  #define EX(v) __builtin_amdgcn_exp2f(v)
  #define GAPB(MF,X,B) do{ MF; X[B]=EX(X[B]); X[B+1]=EX(X[B+1]); X[B+2]=EX(X[B+2]); X[B+3]=EX(X[B+3]); PIN(X); SBAR(); }while(0)
  #define VRD(i) do{ vlo[i]=vtr(vp_+(((i)>>2)*4096+((i)&3)*1024)); vhi[i]=vtr(vp_+(((i)>>2)*4096+((i)&3)*1024+512)); }while(0)
  #define KRD(G,j) do{ if(G){ kload2(kf,kp0+sl_next,j); SBAR(); } }while(0)
  #define STEP(C0,C1,P0,P1,t,GK,GV,GL) do{ SBAR(); \
    const lds_cptr vp_=vp0+sl_prev; \
    VRD(0); SBAR(); float sacc=NOMAX?0.f:(P0[0]+P0[1]); \
    GAPA(C0=__builtin_amdgcn_mfma_f32_32x32x16_bf16(kf[0],qr[0],negm,0,0,0), P0[2],P0[3],P0[4],P0[5],     pw0[0]=PKW(P0,0), pw0[1]=PKW(P0,2), pw0); \
    VRD(4); SBAR(); GAPA(C1=__builtin_amdgcn_mfma_f32_32x32x16_bf16(kf[1],qr[0],negm,0,0,0), P0[6],P0[7],P0[8],P0[9],     pw0[2]=PKW(P0,4), pw0[3]=PKW(P0,6), pw0); \
    VRD(1); SBAR(); GAPA(C0=__builtin_amdgcn_mfma_f32_32x32x16_bf16(kf[2],qr[1],C0,0,0,0),   P0[10],P0[11],P0[12],P0[13], pw1[0]=PKW(P0,8), pw1[1]=PKW(P0,10), pw1); \
    VRD(5); SBAR(); GAPA(C1=__builtin_amdgcn_mfma_f32_32x32x16_bf16(kf[3],qr[1],C1,0,0,0),   P0[14],P0[15],P1[0],P1[1],   pw1[2]=PKW(P0,12),pw1[3]=PKW(P0,14), pw1); \
    VRD(2); SBAR(); GAPA(C0=__builtin_amdgcn_mfma_f32_32x32x16_bf16(kf[4],qr[2],C0,0,0,0),   P1[2],P1[3],P1[4],P1[5],     pw2[0]=PKW(P1,0), pw2[1]=PKW(P1,2), pw2); \
    VRD(6); SBAR(); GAPA(C1=__builtin_amdgcn_mfma_f32_32x32x16_bf16(kf[5],qr[2],C1,0,0,0),   P1[6],P1[7],P1[8],P1[9],     pw2[2]=PKW(P1,4), pw2[3]=PKW(P1,6), pw2); \
    VRD(3); SBAR(); GAPA(C0=__builtin_amdgcn_mfma_f32_32x32x16_bf16(kf[6],qr[3],C0,0,0,0),   P1[10],P1[11],P1[12],P1[13], pw3[0]=PKW(P1,8), pw3[1]=PKW(P1,10), pw3); \
    VRD(7); SBAR(); GAPA2(C1=__builtin_amdgcn_mfma_f32_32x32x16_bf16(kf[7],qr[3],C1,0,0,0),  P1[14],P1[15],               pw3[2]=PKW(P1,12),pw3[3]=PKW(P1,14), pw3); \
    if constexpr(!NOMAX) l_reg+=sacc; \
    if(GK){DMA_K((t)+3,sl_cur);} if(GV){DMA_V((t)+1,sl_next);} \
    CMASK(C0,C1,t); \
    if constexpr(!NOMAX){ float a=MX3(C0[0],C0[1],C1[0]),b=MX3(C0[2],C0[3],C1[1]); a=MX3(a,C1[2],C1[3]); \
      _Pragma("unroll") for(int r=4;r<16;r+=4){a=MX3(a,C0[r],C0[r+1]);b=MX3(b,C0[r+2],C0[r+3]);a=MX3(a,C1[r],C1[r+1]);b=MX3(b,C1[r+2],C1[r+3]);} \
      float rm=__builtin_fmaxf(a,b); { auto rr=__builtin_amdgcn_permlane32_swap(__float_as_uint(rm),__float_as_uint(rm),false,false); rm=__builtin_fmaxf(__uint_as_float(rr[0]),__uint_as_float(rr[1])); } \
      resc=false; \
      if(__builtin_expect(__any(rm>(float)THRL),0)){ const float dl=__builtin_fmaxf(rm,0.f); mhat+=dl; \
        _Pragma("unroll") for(int r=0;r<16;++r){C0[r]-=dl;C1[r]-=dl;} \
        _Pragma("unroll") for(int r=0;r<16;++r)negm[r]=-mhat; asm volatile("":"+v"(negm)); \
        const float f=__builtin_amdgcn_exp2f(-dl); l_reg*=f; if(hi==0)wsf[r32]=f; resc=true; } } \
    SBAR(); \
    GAPB(o[0]=__builtin_amdgcn_mfma_f32_32x32x16_bf16(PAF(0),VFR(0),o[0],0,0,0), C0,0); \
    GAPB(o[1]=__builtin_amdgcn_mfma_f32_32x32x16_bf16(PAF(0),VFR(4),o[1],0,0,0), C0,4); LSUM(0); \
    KRD(GL,0); GAPB(o[0]=__builtin_amdgcn_mfma_f32_32x32x16_bf16(PAF(1),VFR(1),o[0],0,0,0), C0,8); \
    KRD(GL,1); GAPB(o[1]=__builtin_amdgcn_mfma_f32_32x32x16_bf16(PAF(1),VFR(5),o[1],0,0,0), C0,12); LSUM(1); \
    KRD(GL,2); GAPB(o[0]=__builtin_amdgcn_mfma_f32_32x32x16_bf16(PAF(2),VFR(2),o[0],0,0,0), C1,0); \
    KRD(GL,3); GAPB(o[1]=__builtin_amdgcn_mfma_f32_32x32x16_bf16(PAF(2),VFR(6),o[1],0,0,0), C1,4); LSUM(2); \
    GAPB(o[0]=__builtin_amdgcn_mfma_f32_32x32x16_bf16(PAF(3),VFR(3),o[0],0,0,0), C1,8); \
    GAPB(o[1]=__builtin_amdgcn_mfma_f32_32x32x16_bf16(PAF(3),VFR(7),o[1],0,0,0), C1,12); LSUM(3); \
    }while(0)
  int t=1;
  #undef CMASK
  #define CMASK(P0,P1,t) do{}while(0)
  for(;t+5<NT;t+=2){
    STEP(pB0,pB1,pA0,pA1,t,true,true,true);     if(t==1){WAIT_BAR(6);}else{WAIT_BAR(2);} RESC(); ROT();
    STEP(pA0,pA1,pB0,pB1,t+1,true,true,true);   WAIT_BAR(2); RESC(); ROT();
  }
  #undef CMASK
  #define CMASK(P0,P1,t) do{}while(0)
  #define ENDW(tt) do{ if((tt)+3<NT){WAIT_BAR(2);} else if((tt)+2<NT){WAIT_BAR(1);} else {WAIT_BAR(0);} }while(0)
  for(;t+1<NT;t+=2){
    STEP(pB0,pB1,pA0,pA1,t,(t+3<NT),(t+1<NT),(t+1<NT));       ENDW(t);   RESC(); ROT();
    STEP(pA0,pA1,pB0,pB1,t+1,(t+4<NT),(t+2<NT),(t+2<NT));     ENDW(t+1); RESC(); ROT();
  }
  if(nk>=0){ const bf16*kn=K+nk*4096,*vn=V+nk*4096;
    glds16s(kn,kvoff,(unsigned)__builtin_amdgcn_readfirstlane(kdst)); glds16s(vn,kvoff,(unsigned)__builtin_amdgcn_readfirstlane(vdst)); glds16s(kn+4096,kvoff,(unsigned)__builtin_amdgcn_readfirstlane(kdst+SLOTB)); glds16s(kn+2*4096,kvoff,(unsigned)__builtin_amdgcn_readfirstlane(kdst+2*SLOTB));
    const bf16*Qn=Q+nq+(long)wid*QBLK*QP;
    #pragma unroll
    for(int d0=0;d0<4;++d0)qc[d0]=*reinterpret_cast<const bf16x8*>(&Qn[(long)r32*QP+d0*16+hi*8]); }
  STEP(pB0,pB1,pA0,pA1,NT-1,false,false,false); RESC();
  { if constexpr(!NOMAX){ float sacc=pB0[0]+pB0[1]; _Pragma("unroll") for(int r=2;r<16;++r)sacc+=pB0[r]; _Pragma("unroll") for(int r=0;r<16;++r)sacc+=pB1[r]; l_reg+=sacc; }
    pw0=(u32x4){PKW(pB0,0),PKW(pB0,2),PKW(pB0,4),PKW(pB0,6)};pw1=(u32x4){PKW(pB0,8),PKW(pB0,10),PKW(pB0,12),PKW(pB0,14)};pw2=(u32x4){PKW(pB1,0),PKW(pB1,2),PKW(pB1,4),PKW(pB1,6)};pw3=(u32x4){PKW(pB1,8),PKW(pB1,10),PKW(pB1,12),PKW(pB1,14)};
    SBAR(); pv(o,vb0+sl_cur,PAF(0),PAF(1),PAF(2),PAF(3)); LSUM(0); LSUM(1); LSUM(2); LSUM(3); }
  #undef PKW
  #undef PAF
  #undef VFR
  #undef PIN
  #undef MX3
  #undef GAPA
  #undef GAPA2
  #undef LSUM
  #undef GAPB
  #undef EX
  #undef VRD
  #undef KRD
  #undef STEP
  #undef ENDW
  if constexpr(NOMAX){ asm volatile("s_nop 7":"+v"(lsum)); if((lane&16)==0)wsf[32+(lane&15)+((lane>>5)<<4)]=lsum[0]; }
  else{ {auto rr=__builtin_amdgcn_permlane32_swap(__float_as_uint(l_reg),__float_as_uint(l_reg),false,false);l_reg=__uint_as_float(rr[0])+__uint_as_float(rr[1]);}
    if(hi==0)wsf[32+r32]=l_reg; }
  asm volatile("s_waitcnt lgkmcnt(0)":::"memory");
  float rli[16];
  #pragma unroll
  for(int r=0;r<16;++r)rli[r]=__builtin_amdgcn_rcpf(wsf[32+crow(r,hi)]);
  bf16*Ow=O+(qrow0+wid*QBLK)*QP+h*D;
  { bf16*stg=(bf16*)(shm+LDS_OST)+wid*2048; const bf16*zst=(const bf16*)(shm+LDS_ZST)+wid*2048;
    #pragma unroll
    for(int r=0;r<16;++r){const int orow=crow(r,hi);
      #pragma unroll
      for(int d0=0;d0<2;++d0)stg[orow*64+d0*32+r32]=__float2bfloat16(o[d0][r]*rli[r]);}
    asm volatile("s_waitcnt lgkmcnt(0)":::"memory");
    #pragma unroll
    for(int i=0;i<4;++i){const int row=i*8+(lane>>3),ch=lane&7; const u32x4 v=*(const u32x4*)(stg+row*64+ch*8); const u32x4 z=*(const u32x4*)(zst+row*64+ch*8); u32x4 w;
      #pragma unroll
      for(int e=0;e<4;++e){ const float lo=__uint_as_float(v[e]<<16)*__uint_as_float(z[e]<<16), hh=__uint_as_float(v[e]&0xffff0000u)*__uint_as_float(z[e]&0xffff0000u); w[e]=cvtpk_s(lo,hh); }
      ATTN_STORE16(Ow+(long)row*QP+ch*8,w);} }
  asm volatile("s_waitcnt lgkmcnt(0)\n\ts_barrier":::"memory");
  #undef DMA_K
  #undef DMA_V
  #undef CMASK
  #undef START
  #undef RESC
  #undef ROT
}
constexpr int ATTN_LDS_BYTES=LDS_BYTES;
#undef SBAR
#undef WAIT_BAR
}
constexpr size_t MiB = 1u << 20;
constexpr size_t WS_CTL = 0, CTL_ZERO_BYTES = 64 * 1024;
constexpr size_t WS_MOD = 1 * MiB;
constexpr size_t WS_ROPEC = WS_MOD + 256 * 1024, WS_ROPES = WS_ROPEC + 4096;
constexpr size_t WS_W = 2 * MiB, W_LAYER = 23 * MiB, W_IN = 0, W_A = 17 * MiB, W_C = 19 * MiB, W_O = 21 * MiB;
using pg8::e_k; using pg8::e_v; using pg8::e_sza; using pg8::e_u; using pg8::e_yz;
constexpr size_t WS_HX = pg8::E_HX, WS_Q = pg8::E_Q;
constexpr size_t WS_END = 264 * MiB;
__device__ __forceinline__ unsigned char* w_ptr(unsigned char* ws, int l, int which) { return which == 0 ? ws + WS_W + (size_t)l * W_LAYER : l ? ws + WS_W + W_LAYER + (17 + 2 * (which - 1)) * MiB : ws + (258 + 2 * (which - 1)) * MiB; }

constexpr int RING_OFF = 0, RING_BYTES = 131072;
constexpr int LDSCTL_OFF = RING_BYTES, MISC_OFF = LDSCTL_OFF + 320, EPI_TAB_OFF = LDSCTL_OFF + 1024;
constexpr int LDS_BYTES = 147456;
constexpr int NWAVES = 8;
constexpr int N_PHASES = 11;
constexpr int N_LAUNCHES = MK_N_LAUNCHES;
static_assert(N_LAUNCHES == 1 || N_LAUNCHES == N_PHASES, "MK_N_LAUNCHES is 1 or 11");

typedef GAS unsigned gu32;
#define RLX_AGENT __ATOMIC_RELAXED, __HIP_MEMORY_SCOPE_AGENT
#define LDS_WAIT() asm volatile("s_waitcnt lgkmcnt(0)" ::: "memory")
#define VM_WAIT() asm volatile("s_waitcnt vmcnt(0)" ::: "memory")

#define XB_TMO      128
#define XB_XCNT(j)  (256  + 64 * (j))
#define XB_XSUB(j)  (1280 + 64 * (j))
#define XB_XGEN(j)  (2304 + 64 * (j))
#define XB_TOP      3328
#define XB_TOPGEN   3392
#define XCD_BAR_WORDS 3456
#define XB_SPIN_CAP (1u << 18)

__device__ __forceinline__ unsigned xb_ld(unsigned* p)              { return __hip_atomic_load(p, __ATOMIC_RELAXED, __HIP_MEMORY_SCOPE_AGENT); }
__device__ __forceinline__ unsigned xb_add(unsigned* p, unsigned v) { return __hip_atomic_fetch_add(p, v, __ATOMIC_RELAXED, __HIP_MEMORY_SCOPE_AGENT); }
__device__ __forceinline__ unsigned xb_xcc_id() { return (unsigned)__builtin_amdgcn_s_getreg((3 << 11) | 20) & 0xFu; }
#define XB_SPIN(cond, bar) do { unsigned _sp = 0; while (cond) { __builtin_amdgcn_s_sleep(1); \
    if ((++_sp & 255u) == 0u) { if (xb_ld(&(bar)[XB_TMO])) break; if (_sp > XB_SPIN_CAP) { atomicAdd(&(bar)[XB_TMO], 1u); break; } } } } while (0)

struct XcdBarrier {
    unsigned* bar; unsigned x;
    volatile LAS unsigned* st;
};

__device__ __forceinline__ XcdBarrier xcd_barrier_post(unsigned* bar, volatile LAS unsigned* st) {
    XcdBarrier b; b.bar = bar; b.x = xb_xcc_id(); b.st = st;
    if (threadIdx.x == 0) (void)xb_add(&bar[XB_XCNT(b.x)], 1u);
    return b;
}
__device__ __forceinline__ void xcd_barrier_complete(unsigned* bar, unsigned x, unsigned& nloc, unsigned& nx) {
    const unsigned G = gridDim.x * gridDim.y * gridDim.z;
    unsigned sum, cnt, mine, sp = 0u;
    for (;;) {
        sum = 0u; cnt = 0u; mine = 0u;
#pragma unroll
        for (unsigned j = 0; j < 16; ++j) { const unsigned c = xb_ld(&bar[XB_XCNT(j)]); sum += c; cnt += (c > 0u) ? 1u : 0u; mine = (j == x) ? c : mine; }
        if (sum == G) break;
        __builtin_amdgcn_s_sleep(1);
        if ((++sp & 255u) == 0u) { if (xb_ld(&bar[XB_TMO])) break; if (sp > XB_SPIN_CAP) { atomicAdd(&bar[XB_TMO], 1u); break; } }
    }
    nloc = mine > 0u ? mine : 1u; nx = cnt > 0u ? cnt : 1u;
}

__device__ __forceinline__ void xcd_barrier(const XcdBarrier& b) {
    asm volatile("s_waitcnt vmcnt(0)" ::: "memory");
    __syncthreads();
    if (threadIdx.x == 0) {
        unsigned* bar = b.bar;
        __builtin_amdgcn_s_waitcnt(0);
        unsigned nloc = b.st[0], nx = b.st[1];
        if (nloc == 0u) { xcd_barrier_complete(bar, b.x, nloc, nx); b.st[0] = nloc; b.st[1] = nx; }
        const unsigned old = xb_add(&bar[XB_XSUB(b.x)], 1u);
        const unsigned gen = old / nloc;
        if (old + 1u == (gen + 1u) * nloc) {
            __builtin_amdgcn_fence(__ATOMIC_RELEASE, "agent");
            asm volatile("s_waitcnt vmcnt(0)" ::: "memory");
            const unsigned og = xb_add(&bar[XB_TOP], 1u);
            const unsigned tg = og / nx;
            if (og + 1u == (tg + 1u) * nx) {
#pragma unroll
                for (unsigned j = 0; j < 16; ++j) (void)xb_add(&bar[XB_XGEN(j)], 1u);
            } else XB_SPIN(xb_ld(&bar[XB_XGEN(b.x)]) == gen, bar);
            __builtin_amdgcn_fence(__ATOMIC_ACQUIRE, "agent");
            asm volatile("s_waitcnt vmcnt(0)" ::: "memory");
        } else {
            XB_SPIN(xb_ld(&bar[XB_XGEN(b.x)]) == gen, bar);
            __builtin_amdgcn_fence(__ATOMIC_ACQUIRE, "agent");
            asm volatile("s_waitcnt vmcnt(0)" ::: "memory");
        }
    }
    __syncthreads();
}


constexpr int CW_BAR = 1024;
static_assert((CW_BAR + XCD_BAR_WORDS) * 4 <= (int)CTL_ZERO_BYTES, "control words inside the memset region");
static_assert(attn_body::ATTN_LDS_BYTES <= RING_BYTES, "attention scratch inside the ring region");


__device__ __forceinline__ float wave_max(float v) {
#pragma unroll
    for (int o = 1; o < 64; o <<= 1) v = fmaxf(v, __shfl_xor(v, o));
    return v;
}
__device__ __forceinline__ float wave_sum(float v) {
#pragma unroll
    for (int o = 1; o < 64; o <<= 1) v += __shfl_xor(v, o);
    return v;
}
__device__ __forceinline__ unsigned f2bf(float f) { unsigned u = __builtin_bit_cast(unsigned, f); return (u + 0x7fffu + ((u >> 16) & 1u)) >> 16; }
__device__ __forceinline__ unsigned pk2(float lo, float hi) { return f2bf(lo) | (f2bf(hi) << 16); }

__device__ __forceinline__ int wmap_sq(int n) { const int c = n & 255; return (n & ~255) + (c & 0xe0) + 8 * ((c >> 2) & 3) + 4 * ((c >> 4) & 1) + (c & 3); }
__device__ __forceinline__ int wmap_in(int n) {
    const int pn = n >> 8, c = n & 255, wc = (c >> 5) & 3, bj = c >> 7, nn = (c >> 4) & 1, fq = (c >> 2) & 3, i = c & 3;
    const int l8 = 8 * fq + 4 * nn + i, dd = 32 * (fq >> 1) + 8 * (fq & 1) + 16 * bj + 4 * nn + i;
    if (pn < 4) return 256 * pn + 64 * wc + dd;
    if (pn == 4) return 1024 + 64 * wc + dd;
    if (pn == 5) return 1280 + 128 * bj + 32 * wc + l8;
    if (pn < 10) return 1536 + 256 * (pn - 6) + 128 * bj + 32 * wc + l8;
    if (pn < 18) return (bj ? 4608 : 2560) + 128 * (pn - 10) + 32 * wc + l8;
    if (pn < 26) return (bj ? 5632 : 3584) + 128 * (pn - 18) + 32 * wc + l8;
    return 6656 + 256 * (pn - 26) + 128 * bj + 32 * wc + l8;
}
template <bool IN> __device__ __forceinline__ void transpose_item(const float* W, int N, bf16_t* WT, LAS float* scr, int item, int lane) {
    const int nblk = N / 32, kb = item / nblk, nb = item % nblk, k0 = 64 * kb, n0 = 32 * nb;
    const int jq = lane & 7, ks = lane >> 3; const int scol = IN ? wmap_in(n0 + 4 * jq) : wmap_sq(n0 + 4 * jq);
    f32x4 wv[8];
#pragma unroll
    for (int i = 0; i < 8; ++i) wv[i] = __builtin_nontemporal_load((const f32x4*)(W + (size_t)(k0 + 8 * i + ks) * N + scol));
    if (IN && ((scol >= 1536 && scol < 2560) || (scol >= 5632 && scol < 6656))) {
#pragma unroll
        for (int i = 0; i < 8; ++i) wv[i] = wv[i] * -1.4426950408889634f; }
    asm volatile("" ::: "memory");
#pragma unroll
    for (int i = 0; i < 8; ++i) { LAS float* d = scr + (8 * i + ks) * 33 + 4 * jq; d[0] = wv[i][0]; d[1] = wv[i][1]; d[2] = wv[i][2]; d[3] = wv[i][3]; }
    LDS_WAIT(); asm volatile("" ::: "memory");
    const int c = lane & 7;
#pragma unroll
    for (int j = 0; j < 4; ++j) { const int n = (lane >> 3) + 8 * j; const LAS float* s = scr + (8 * c) * 33 + n;
        u32x4 o; o.x = pk2(s[0 * 33], s[1 * 33]); o.y = pk2(s[2 * 33], s[3 * 33]); o.z = pk2(s[4 * 33], s[5 * 33]); o.w = pk2(s[6 * 33], s[7 * 33]);
        *(GAS u32x4*)(WT + (size_t)(n0 + n) * 1024 + k0 + 8 * c) = o; }
    LDS_WAIT(); asm volatile("" ::: "memory");
}

struct Frame {
    LAS unsigned char* lds; int tid, lane, wave, vcu, G;
    unsigned char* ws; int z;
};

#ifndef ATT_THR
#define ATT_THR 8
#endif
#ifndef TAIL_A
#define TAIL_A 3
#define TAIL_B 4
#endif
__device__ __forceinline__ void p0_prologue(Frame& F, const Args& A) {
    {
        LAS float* sc = (LAS float*)(F.lds + RING_OFF);
        LAS float* red = sc + 9 * 1024;
        bool have = false;
        for (int item = F.vcu; item < 256; item += F.G) {
            const int l = item >> 7, n0 = (item & 127) * 24;
            const int q = F.tid % 6, kg = F.tid / 6;
            f32x4 wv[16]; f32x4 a[9];
            if (F.tid < 384) { const float* w = ARGP(A, I_WADA, F.z) + (size_t)l * 1024 * 3072 + n0 + 4 * q;
#pragma unroll
                for (int i = 0; i < 16; ++i) wv[i] = __builtin_nontemporal_load((const f32x4*)(w + (size_t)(kg * 16 + i) * 3072)); }
            if (!have) { const float* cp = ARGP(A, I_C, F.z); const float* cc = ARGP(A, I_CCTX, F.z); float cv[18];
#pragma unroll
                for (int q2 = 0; q2 < 18; ++q2) { const int e = F.tid + q2 * (NWAVES * 64); cv[q2] = e < 8192 ? cp[e] : cc[e - 8192]; }
                asm volatile("" ::: "memory");
#pragma unroll
                for (int q2 = 0; q2 < 18; ++q2) sc[F.tid + q2 * (NWAVES * 64)] = silu_f(cv[q2]);
                have = true; __syncthreads(); }
            if (F.tid < 384) {
#pragma unroll
                for (int j = 0; j < 9; ++j) a[j] = (f32x4){0.f, 0.f, 0.f, 0.f};
                asm volatile("" ::: "memory");
#pragma unroll
                for (int i = 0; i < 16; ++i)
#pragma unroll
                    for (int j = 0; j < 9; ++j) a[j] += wv[i] * sc[j * 1024 + kg * 16 + i];
#pragma unroll
                for (int j = 0; j < 9; ++j) *(LAS f32x4*)(red + (kg * 9 + j) * 24 + 4 * q) = a[j]; }
            __syncthreads();
            if (F.tid < 216) { const int j = F.tid / 24, col = F.tid % 24; float s = ARGP(A, I_BADA, F.z)[l * 3072 + n0 + col];
#pragma unroll 8
                for (int g = 0; g < 64; ++g) s += red[(g * 9 + j) * 24 + col];
                ((float*)(F.ws + WS_MOD))[(size_t)(l * 9 + j) * 3072 + n0 + col] = s; }
            __syncthreads();
        }
    }
    if (F.vcu == F.G - 1) { for (int e = F.tid; e < 1024; e += NWAVES * 64) { const int pos = e >> 4, j = e & 15;
            const float inv = __builtin_amdgcn_exp2f(-(float)(2 * j) * (13.287712379549449f / 32.0f)), rev = (float)pos * inv * 0.15915494309189535f;
            ((float*)(F.ws + WS_ROPEC))[e] = __builtin_amdgcn_cosf(rev); ((float*)(F.ws + WS_ROPES))[e] = __builtin_amdgcn_sinf(rev); } }
}
__device__ __forceinline__ void weight_copies(Frame& F, const Args& A, int it_lo, int it_hi, int gw, int NGW) {
    LAS float* scr = (LAS float*)(F.lds + RING_OFF + F.wave * 16384);
    constexpr int I_IN = 16 * (PROJ / 32), I_SQ = 16 * 32, PER_L = I_IN + 3 * I_SQ;
    for (int it = it_lo + gw; it < it_hi; it += NGW) {
        const int l = it / PER_L; int r = it % PER_L;
        if (r < I_IN) { transpose_item<true>(ARGP(A, I_WIN, F.z) + (size_t)l * 1024 * PROJ, PROJ, (bf16_t*)w_ptr(F.ws, l, 0), scr, r, F.lane); continue; } r -= I_IN;
        if (r < I_SQ) { transpose_item<false>(ARGP(A, I_WABR, F.z) + (size_t)l * 1024 * 1024, 1024, (bf16_t*)w_ptr(F.ws, l, 1), scr, r, F.lane); continue; } r -= I_SQ;
        if (r < I_SQ) { transpose_item<false>(ARGP(A, I_WCBR, F.z) + (size_t)l * 1024 * 1024, 1024, (bf16_t*)w_ptr(F.ws, l, 2), scr, r, F.lane); continue; } r -= I_SQ;
        transpose_item<false>(ARGP(A, I_WOUT, F.z) + (size_t)l * 1024 * 1024, 1024, (bf16_t*)w_ptr(F.ws, l, 3), scr, r, F.lane);
    }
}
constexpr int WC_IN0 = 16 * (PROJ / 32), WC_ALL = 2 * (16 * (PROJ / 32) + 3 * 16 * 32);

__device__ __forceinline__ void modulate_phase(Frame& F, const Args& A, int l, const float* xs, int rlo, int rhi, int gw, int NGW) {
    const float* mod = (const float*)(F.ws + WS_MOD) + (size_t)l * 9 * 3072; const float* ng = ARGP(A, I_NORMG, F.z) + l * 1024;
    bf16_t* HX = (bf16_t*)(F.ws + WS_HX);
    const int R = (rhi - rlo + NGW - 1) / NGW; const int ra = rlo + gw * R; int rb = ra + R; if (rb > rhi) rb = rhi;
    f32x4 Gv[4], Sv[4]; int jcur = -1;
    for (int r0 = ra; r0 < rb; r0 += 2) {
        const bool two = r0 + 1 < rb; const int rr[2] = {r0, two ? r0 + 1 : r0};
        f32x4 v[2][4]; float s[2] = {0.f, 0.f}; u32x2 w16[2][4]; const bool b16 = l && r0 < NLAT;
#pragma unroll
        for (int u = 0; u < 2; ++u) { const int r = rr[u];
            if (b16) { const u32x2* xr = (const u32x2*)((const bf16_t*)(F.ws + pg8::E_X1B) + (size_t)r * DM) + F.lane;
#pragma unroll
                for (int q = 0; q < 4; ++q) w16[u][q] = __builtin_nontemporal_load(xr + 64 * q);
            } else if (r >= NLAT && l) {
#pragma unroll
                for (int q = 0; q < 4; ++q) v[u][q] = ((const f32x4*)pg8::ctx1_half(F.ws, r - NLAT, q >> 1))[F.lane + 64 * (q & 1)];
            } else { const float* xrow = r < NLAT ? xs + (size_t)r * DM : ARGP(A, I_CTX, F.z) + (size_t)(r - NLAT) * DM; const f32x4* xr = (const f32x4*)xrow + F.lane;
#pragma unroll
                for (int q = 0; q < 4; ++q) v[u][q] = __builtin_nontemporal_load(xr + 64 * q); } }
        asm volatile("" ::: "memory");
        if (b16) {
#pragma unroll
            for (int u = 0; u < 2; ++u)
#pragma unroll
                for (int q = 0; q < 4; ++q) v[u][q] = (f32x4){__uint_as_float(w16[u][q].x << 16), __uint_as_float(w16[u][q].x & 0xffff0000u), __uint_as_float(w16[u][q].y << 16), __uint_as_float(w16[u][q].y & 0xffff0000u)}; }
#pragma unroll
        for (int u = 0; u < 2; ++u)
#pragma unroll
            for (int q = 0; q < 4; ++q) s[u] += (v[u][q].x * v[u][q].x + v[u][q].y * v[u][q].y) + (v[u][q].z * v[u][q].z + v[u][q].w * v[u][q].w);
#pragma unroll
        for (int u = 0; u < 2; ++u) { if (u == 1 && !two) break; const int r = rr[u], j = r < NLAT ? (r >> 11) : 8;
            if (j != jcur) { jcur = j;
                const f32x4* sh = (const f32x4*)(mod + (size_t)j * 3072) + F.lane; const f32x4* scl = (const f32x4*)(mod + (size_t)j * 3072 + 1024) + F.lane; const f32x4* g4 = (const f32x4*)ng + F.lane;
#pragma unroll
                for (int q = 0; q < 4; ++q) { Gv[q] = g4[64 * q] * (scl[64 * q] + 1.0f); Sv[q] = sh[64 * q]; } }
            const float rstd = __builtin_amdgcn_rsqf(wave_sum(s[u]) * (1.0f / DM) + EPS);
            unsigned long long* o8 = (unsigned long long*)(HX + (size_t)r * DM) + F.lane;
#pragma unroll
            for (int q = 0; q < 4; ++q) { const f32x4 y = v[u][q] * rstd * Gv[q] + Sv[q];
                o8[64 * q] = (unsigned long long)cvt_pk_bf16(y.x, y.y) | ((unsigned long long)cvt_pk_bf16(y.z, y.w) << 32); } }
    }
}

__device__ __forceinline__ void conv_phase(Frame& F, const Args& A, int l, int nrows) {
    const bf16_t* U = (const bf16_t*)(F.ws + e_u(l)); bf16_t* YZL = (bf16_t*)(F.ws + e_yz(l)); bf16_t* YZC = (bf16_t*)(F.ws + pg8::E_YZC) - (size_t)NLAT * DM;
    const int ch = (F.tid & 127) * 8, rg = F.tid >> 7;
    const float* cw = ARGP(A, I_CONVW, F.z) + (size_t)l * 3 * 1024 + ch; const float* cb = ARGP(A, I_CONVB, F.z) + (size_t)l * 1024 + ch;
    float w0[8], w1[8], w2[8], bb[8];
#pragma unroll
    for (int e = 0; e < 8; ++e) { w0[e] = cw[e]; w1[e] = cw[1024 + e]; w2[e] = cw[2048 + e]; bb[e] = cb[e]; }
    const int nitems = (nrows + 71) / 72;
    for (int item = F.vcu; item < nitems; item += F.G) {
        const int r0 = item * 72 + rg * 18; int r1 = r0 + 18; if (r1 > nrows) r1 = nrows;
        if (r0 >= r1) continue;
        const u32x4 z4 = {0u, 0u, 0u, 0u};
        auto seqmask = [](int r) { return r < NLAT ? (SEQ - 1) : (CTXL - 1); };
        u32x4 up = ((r0 & seqmask(r0)) != 0) ? __builtin_nontemporal_load((const u32x4*)(U + (size_t)(r0 - 1) * DM + ch)) : z4;
        u32x4 uc = __builtin_nontemporal_load((const u32x4*)(U + (size_t)r0 * DM + ch));
        for (int rb = r0; rb < r1; rb += 6) {
            u32x4 un6[6], w6[6];
#pragma unroll
            for (int q = 0; q < 6; ++q) { const int r = rb + q; const bool ok = r < r1;
                un6[q] = (ok && r + 1 < NROW) ? __builtin_nontemporal_load((const u32x4*)(U + (size_t)(r + 1) * DM + ch)) : z4;
                w6[q] = ok ? __builtin_nontemporal_load((const u32x4*)((r < NLAT ? YZL : YZC) + (size_t)r * DM + ch)) : z4; }
            asm volatile("" ::: "memory");
#pragma unroll
            for (int q = 0; q < 6; ++q) { const int r = rb + q; if (r >= r1) break;
                const int sm = seqmask(r);
                const u32x4 unr = un6[q], un = ((r & sm) != sm) ? unr : z4, wv = w6[q];
                if ((r & sm) == 0) up = z4;
                u32x4 o;
#pragma unroll
                for (int e = 0; e < 4; ++e) {
                    const float ylo = bf_lo(wv[e]) * (w0[2 * e] * bf_lo(up[e]) + w1[2 * e] * bf_lo(uc[e]) + w2[2 * e] * bf_lo(un[e]) + bb[2 * e]);
                    const float yhi = bf_hi(wv[e]) * (w0[2 * e + 1] * bf_hi(up[e]) + w1[2 * e + 1] * bf_hi(uc[e]) + w2[2 * e + 1] * bf_hi(un[e]) + bb[2 * e + 1]);
                    o[e] = cvt_pk_bf16(ylo, yhi); }
                *(u32x4*)((r < NLAT ? YZL : YZC) + (size_t)r * DM + ch) = o;
                up = uc; uc = unr; }
        }
    }
}

constexpr int CW_GRP = 8192;
__device__ __forceinline__ void group_sync(unsigned* ctl, int g, unsigned k) {
    asm volatile("s_waitcnt vmcnt(0)" ::: "memory");
    __syncthreads();
    if (threadIdx.x == 0) {
        unsigned* cnt = ctl + CW_GRP + 64 * g;
        __builtin_amdgcn_fence(__ATOMIC_RELEASE, "agent");
        asm volatile("s_waitcnt vmcnt(0)" ::: "memory");
        __hip_atomic_fetch_add(cnt, 1u, __ATOMIC_RELAXED, __HIP_MEMORY_SCOPE_AGENT);
        unsigned sp = 0;
        while (__hip_atomic_load(cnt, __ATOMIC_RELAXED, __HIP_MEMORY_SCOPE_AGENT) < 4u * k) { __builtin_amdgcn_s_sleep(2); if (++sp > (1u << 22)) break; }
        __builtin_amdgcn_fence(__ATOMIC_ACQUIRE, "agent");
        asm volatile("s_waitcnt vmcnt(0)" ::: "memory");
    }
    __syncthreads();
}

__global__ void __launch_bounds__(NWAVES * 64, 2) mk_fwd(Args args) {
    extern __shared__ __attribute__((aligned(16))) unsigned char lds[];
    { int t0 = threadIdx.x; for (int u = t0; u < (LDS_BYTES - LDSCTL_OFF) / 4; u += NWAVES * 64) ((LAS unsigned*)((LAS unsigned char*)lds + LDSCTL_OFF))[u] = 0u; }
    __syncthreads();
    XcdBarrier bar; bar.bar = (unsigned*)(args.ws + WS_CTL) + CW_BAR; bar.x = 0; bar.st = nullptr;
    if (N_LAUNCHES == 1) bar = xcd_barrier_post((unsigned*)(args.ws + WS_CTL) + CW_BAR, (volatile LAS unsigned*)((LAS unsigned char*)lds + MISC_OFF) + 8);

    int ph = args.ph_lo, sub = 0;
    while (ph < args.ph_hi) {
        int tid = threadIdx.x; asm volatile("" : "+v"(tid));
        size_t zoff = 0; asm volatile("" : "+s"(zoff));
        unsigned char* ws = args.ws + zoff; float* outp = args.out + zoff;
        Frame F; F.lds = (LAS unsigned char*)lds; F.tid = tid; F.lane = tid & 63; F.wave = __builtin_amdgcn_readfirstlane(tid >> 6);
        F.G = gridDim.x; { const int bx = blockIdx.x; F.vcu = (F.G % 8 == 0) ? (bx % 8) * (F.G / 8) + bx / 8 : bx; }
        F.ws = ws; F.z = 0; asm volatile("" : "+s"(F.z));
        const int c = (int)blockIdx.x, G = F.G; const int pl = ph >= 6 ? 1 : 0; const int plp = ph == 0 ? -1 : ph == 1 || ph == 6 ? 0 : (ph - (pl ? 7 : 2)) + 1;
        const bool tailph = (ph == 7), cx = tailph && c < 32; const int grp = c & 7, mem = c >> 3, cpm = 64 + grp;
        const bool tail = cx && sub < 3;
        const int lp = tail ? (sub == 0 ? 3 : sub == 1 ? 4 : 0) : plp;
        const int l = (tail && sub < 2) ? 0 : pl;
        const float* xs = ARGP(args, I_X, F.z);
        if (lp == -1) p0_prologue(F, args);
        else if (lp == 0) {
            if (tail) modulate_phase(F, args, 1, xs, NLAT + 256 * grp + 64 * mem, NLAT + 256 * grp + 64 * mem + 64, F.wave, NWAVES);
            else { if (!l) weight_copies(F, args, 0, WC_IN0, F.vcu * NWAVES + F.wave, F.G * NWAVES); modulate_phase(F, args, l, xs, 0, l ? NLAT : NROW, F.vcu * NWAVES + F.wave, F.G * NWAVES); }
        } else if (lp == 2) {
            const attn_body::bf16* Qp = (const attn_body::bf16*)(ws + WS_Q); const attn_body::bf16* Kp = (const attn_body::bf16*)(ws + e_k(l)); const attn_body::bf16* Vp = (const attn_body::bf16*)(ws + e_v(l));
            const attn_body::bf16* Zp = (const attn_body::bf16*)(ws + e_sza(l)); const int cslot = F.vcu & 3; int i = 0;
            bool fast; { const float gq = fabsf(ARGP(args, I_QNG, F.z)[l * 64 + F.lane]), gk = fabsf(ARGP(args, I_KNG, F.z)[l * 64 + F.lane]);
                fast = wave_max(gq) * wave_max(gk) * (0.18033688f * 64.0f * 1.02f) <= 60.0f; }
            bool pre = false; attn_body::bf16x8 qc[4];
#pragma unroll
            for (int d0 = 0; d0 < 4; ++d0) qc[d0] = (attn_body::bf16x8){0, 0, 0, 0, 0, 0, 0, 0};
            for (int id = F.vcu; id < 1024; id += F.G, ++i) { if (i == cslot) { conv_phase(F, args, l, l ? NLAT : NROW); }
                const int b = (id & 255) >> 5, h = 4 * (id >> 8) + ((id & 31) >> 3), qb = id & 7;
                const int idn = id + F.G; const bool pf = idn < 1024;
                const long nk = pf ? (long)((((idn & 255) >> 5) * 4 + (idn >> 8)) * 36) : -1;
                const long nq = ((long)((idn & 255) >> 5) * 2048 + (idn & 7) * 256) * 1024 + (4 * (idn >> 8) + ((idn & 31) >> 3)) * 64;
                if (fast) attn_body::attn_unit<ATT_THR, true>((long)b * 2048 + qb * 256, h, (long)(b * 4 + (h >> 2)) * 36, h >> 2, 36, Qp, Kp, Vp, Zp, (attn_body::bf16*)(ws + WS_Q), (char*)lds + RING_OFF, pre, nk, nq, qc);
                else attn_body::attn_unit<ATT_THR, false>((long)b * 2048 + qb * 256, h, (long)(b * 4 + (h >> 2)) * 36, h >> 2, 36, Qp, Kp, Vp, Zp, (attn_body::bf16*)(ws + WS_Q), (char*)lds + RING_OFF, pre, nk, nq, qc);
                pre = pf; }
            if (i <= cslot) { conv_phase(F, args, l, l ? NLAT : NROW); }
            if (!l) for (int id = F.vcu; id < 128; id += F.G) { const int b = id >> 4, h = id & 15;
                if (fast) attn_body::attn_unit<ATT_THR, true>((long)16384 + b * 256, h, (long)(b * 4 + (h >> 2)) * 36, h >> 2, 4, Qp, Kp, Vp, Zp, (attn_body::bf16*)(ws + WS_Q), (char*)lds + RING_OFF, false, -1, 0, qc);
                else attn_body::attn_unit<ATT_THR, false>((long)16384 + b * 256, h, (long)(b * 4 + (h >> 2)) * 36, h >> 2, 4, Qp, Kp, Vp, Zp, (attn_body::bf16*)(ws + WS_Q), (char*)lds + RING_OFF, false, -1, 0, qc); }
        } else {
            pg8::GSched S; S.base = c; S.stride = G; S.cnt = 1 << 20; S.xlast = -1; S.npre = 0; S.nx = 0; S.xpm = cpm; S.xpn = mem; S.xk0 = 0; S.xk1 = 0; S.A1 = nullptr; S.B1 = nullptr; S.pn0 = 0; S.nM = 64; S.nN = 4;
            pg8::EpiP E; E.ws = ws; E.out = outp; E.l = l; E.tab = (const LAS float*)((LAS unsigned char*)lds + EPI_TAB_OFF);
            if (lp == 1) {
                LAS float* tb = (LAS float*)((LAS unsigned char*)lds + EPI_TAB_OFF);
                { const f32x4 v = ((const f32x4*)(ws + WS_ROPEC))[tid & 255]; const f32x4 w = ((const f32x4*)(ws + WS_ROPES))[tid & 255]; if (tid < 256) ((LAS f32x4*)tb)[tid] = v; else ((LAS f32x4*)(tb + 1024))[tid - 256] = w; }
                if (tid < 32) ((LAS f32x4*)(tb + 2048))[tid] = tid < 16 ? ((const f32x4*)(ARGP(args, I_QNG, F.z) + l * 64))[tid] : ((const f32x4*)(ARGP(args, I_KNG, F.z) + l * 64))[tid - 16];
                __syncthreads(); }
            if (lp == 1) { S.mode = 0; S.nN = 34; S.nM = l ? 64 : 72; S.A0 = (const char*)(ws + WS_HX); S.B0 = (const char*)w_ptr(ws, l, 0);
                if (tailph) {
                    constexpr int TA = TAIL_A, TB = TAIL_B, TX = 160 - 16 * (TA + TB);
                    if (c >= 32) { S.base = c - 32; S.stride = G - 32; S.cnt = 9; if (c - 32 < TX) S.xlast = 2016 + (c - 32); }
                    else if (c < 16) { S.base = 2016 + TX + c; S.stride = 16; S.cnt = TA; S.npre = 1; S.xpn = 4 + mem; S.xk0 = mem ? pg8::EK_V : pg8::EK_K; }
                    else { S.base = 2016 + TX + 16 * TA + (c - 16); S.stride = 16; S.cnt = TB; } } }
            else if (lp == 3) { S.mode = 1; S.A0 = (const char*)(ws + WS_Q); S.B0 = (const char*)w_ptr(ws, l, 1); S.A1 = (const char*)(ws + e_yz(l)); S.B1 = (const char*)w_ptr(ws, l, 2);
                if (tail) { S.mode = 3; S.nx = 2; S.A0 += (size_t)cpm * pg8::TSTEP; S.B0 += (size_t)mem * pg8::TSTEP; S.A1 = (const char*)(ws + pg8::E_YZC) + (size_t)grp * pg8::TSTEP; S.B1 += (size_t)mem * pg8::TSTEP; S.xk0 = pg8::EK_BR1; S.xk1 = pg8::EK_BR2; } }
            else { S.mode = 2; S.A0 = (const char*)(ws + WS_HX); S.B0 = (const char*)w_ptr(ws, l, 3);
                if (tail) { S.mode = 3; S.nx = 1; S.A0 += (size_t)cpm * pg8::TSTEP; S.B0 += (size_t)mem * pg8::TSTEP; S.xk0 = pg8::EK_OUT; } }
            S.nwg = S.nM * S.nN;
            if (lp == 3) pg8::gemm_phase<true>(F.lds + RING_OFF, S, E, args, tid); else pg8::gemm_phase<false>(F.lds + RING_OFF, S, E, args, tid);
            if (lp == 1 && !l && G == 256 && c >= 144) weight_copies(F, args, WC_IN0, WC_ALL, (c - 144) * NWAVES + F.wave, 112 * NWAVES);
        }
        if (tail) { group_sync((unsigned*)(ws + WS_CTL), grp, (unsigned)(sub + 1)); ++sub; continue; }
        sub = 0;
        if (ph + 1 < args.ph_hi) { XcdBarrier b2 = bar; unsigned* bp = (unsigned*)(ws + WS_CTL) + CW_BAR; unsigned bx = bar.x; asm volatile("" : "+s"(bx)); b2.bar = bp; b2.x = bx; xcd_barrier(b2); }
        ++ph;
    }
}

extern "C" void kernel_launch(void* const* d_in, const int* in_sizes, int n_in, void* d_out, int out_size, void* d_ws, size_t ws_size, hipStream_t stream) {
    static int grid = 0;
    if (grid == 0) {
        if (n_in != 16 || in_sizes[0] != NLAT * DM || out_size != NLAT * DM || ws_size < WS_END) { fprintf(stderr, "kernel_launch: unexpected shapes / workspace (n_in %d, out %d, ws %zu); nothing launched\n", n_in, out_size, ws_size); grid = -1; return; }
        int dev = 0, cus = 0, per_cu = 0;
        if (hipGetDevice(&dev) != hipSuccess || hipDeviceGetAttribute(&cus, hipDeviceAttributeMultiprocessorCount, dev) != hipSuccess) { grid = -1; return; }
        if (hipFuncSetAttribute((const void*)mk_fwd, hipFuncAttributeMaxDynamicSharedMemorySize, LDS_BYTES) != hipSuccess) { fprintf(stderr, "kernel_launch: hipFuncSetAttribute failed\n"); grid = -1; return; }
        if (hipOccupancyMaxActiveBlocksPerMultiprocessor(&per_cu, (const void*)mk_fwd, NWAVES * 64, LDS_BYTES) != hipSuccess || per_cu < 1) { fprintf(stderr, "kernel_launch: occupancy query reports %d workgroups per CU\n", per_cu); (void)hipGetLastError(); grid = -1; return; }
        (void)hipGetLastError();
        if (cus != 256) { fprintf(stderr, "kernel_launch: built for a 256-CU device (the context tail's tile distribution), found %d\n", cus); grid = -1; return; }
        grid = cus;
    }
    if (grid < 0) return;
    if (hipMemsetAsync((char*)d_ws + WS_CTL, 0, CTL_ZERO_BYTES, stream) != hipSuccess) return;
    Args a{};
    for (int i = 0; i < 16; ++i) a.in[i] = (const float*)d_in[i];
    a.out = (float*)d_out; a.ws = (unsigned char*)d_ws;
    for (int li = 0; li < N_LAUNCHES; ++li) {
        a.ph_lo = (N_LAUNCHES == 1) ? 0 : li; a.ph_hi = (N_LAUNCHES == 1) ? N_PHASES : li + 1;
        hipLaunchKernelGGL(mk_fwd, dim3(grid), dim3(NWAVES * 64), LDS_BYTES, stream, a);
    }
}
```
